# Optimizing an MI355X kernel written in HIP

```python
import math
import jax, jax.numpy as jnp
from jax import lax
import numpy as np

D_MODEL = 2048
BATCH = 1
SEQ = 16384
DEPTH = 1

MOBA_HEADS = 8
MOBA_HEAD_DIM = 128
MOBA_WIDTH = MOBA_HEADS * MOBA_HEAD_DIM
MOBA_BLOCK = 256
MOBA_TOPK = 3
MOBA_Q_CHUNK = 64
PARTIAL_ROPE_DIM = MOBA_HEAD_DIM // 4
MLA_HEADS = 8
MLA_NOPE_DIM = 128
MLA_ROPE_DIM = 64
MLA_V_DIM = 128
MLA_Q_RANK = 512
MLA_KV_RANK = 256
MLA_WIDTH = MLA_HEADS * MLA_V_DIM
MLA_Q_BLOCK = 128
ROPE_THETA = 500000.0
D_FF = -(-8 * D_MODEL // (3 * 256)) * 256
EPS = 1e-6
N_BRANCHES = 2
IN_SIZES = (MOBA_WIDTH, MOBA_WIDTH, MOBA_WIDTH, MLA_Q_RANK, MLA_KV_RANK, MLA_ROPE_DIM, N_BRANCHES * D_MODEL)
IN_COLS = sum(IN_SIZES)

kernel_name = "hybrid_moba_mla_gated_block"


def rmsnorm(x, g):
    x32 = x.astype(jnp.float32)
    y = x32 * lax.rsqrt(jnp.mean(x32 * x32, axis=-1, keepdims=True) + EPS)
    return (y * g.astype(jnp.float32)).astype(x.dtype)


def rope(x, positions):
    d = x.shape[-1]
    inv_freq = ROPE_THETA ** (-jnp.arange(0, d, 2, dtype=jnp.float32) / d)
    ang = positions.astype(jnp.float32)[..., None] * inv_freq
    cos = jnp.cos(ang)[:, :, None, :]
    sin = jnp.sin(ang)[:, :, None, :]
    x32 = x.astype(jnp.float32)
    x1, x2 = x32[..., : d // 2], x32[..., d // 2:]
    out = jnp.concatenate([x1 * cos - x2 * sin, x2 * cos + x1 * sin], axis=-1)
    return out.astype(x.dtype)


def moba_attention(q, k, v):
    B, S, H, Dh = q.shape
    nb = -(-S // MOBA_BLOCK)
    n_sel = min(MOBA_TOPK, nb)
    pad = nb * MOBA_BLOCK - S
    kp = jnp.pad(k, ((0, 0), (0, pad), (0, 0), (0, 0)))
    vp = jnp.pad(v, ((0, 0), (0, pad), (0, 0), (0, 0)))
    kb = kp.reshape(B, nb, MOBA_BLOCK, H, Dh).transpose(0, 3, 1, 2, 4)
    vb = vp.reshape(B, nb, MOBA_BLOCK, H, Dh).transpose(0, 3, 1, 2, 4)
    k_mean = jnp.mean(kb.astype(jnp.float32), axis=3)
    scale = Dh ** -0.5
    bidx = jnp.arange(B)[:, None, None, None]
    hidx = jnp.arange(H)[None, None, :, None]

    def chunk(c):
        start = c * MOBA_Q_CHUNK
        qc = lax.dynamic_slice_in_dim(q, start, MOBA_Q_CHUNK, axis=1)
        blk = start // MOBA_BLOCK
        qpos = start + jnp.arange(MOBA_Q_CHUNK)
        gate = jnp.einsum('bqhd,bhnd->bqhn', qc.astype(jnp.float32), k_mean)
        past = jnp.arange(nb) < blk
        gate = jnp.where(past[None, None, None, :], gate, -jnp.inf)
        _, sel = lax.top_k(gate, n_sel)
        sel_valid = jnp.arange(n_sel) < blk
        k_sel = kb[bidx, hidx, sel]
        v_sel = vb[bidx, hidx, sel]
        s_sel = jnp.einsum('bqhd,bqhkjd->bqhkj', qc, k_sel).astype(jnp.float32) * scale
        s_sel = jnp.where(sel_valid[None, None, None, :, None], s_sel, -jnp.inf)
        s_sel = s_sel.reshape(B, MOBA_Q_CHUNK, H, n_sel * MOBA_BLOCK)
        k_own = lax.dynamic_slice_in_dim(kp, blk * MOBA_BLOCK, MOBA_BLOCK, axis=1)
        v_own = lax.dynamic_slice_in_dim(vp, blk * MOBA_BLOCK, MOBA_BLOCK, axis=1)
        s_own = jnp.einsum('bqhd,bjhd->bqhj', qc, k_own).astype(jnp.float32) * scale
        kpos = blk * MOBA_BLOCK + jnp.arange(MOBA_BLOCK)
        causal = kpos[None, :] <= qpos[:, None]
        s_own = jnp.where(causal[None, :, None, :], s_own, -jnp.inf)
        p = jax.nn.softmax(jnp.concatenate([s_sel, s_own], axis=-1), axis=-1).astype(v.dtype)
        p_sel = p[..., : n_sel * MOBA_BLOCK].reshape(B, MOBA_Q_CHUNK, H, n_sel, MOBA_BLOCK)
        p_own = p[..., n_sel * MOBA_BLOCK:]
        return (jnp.einsum('bqhkj,bqhkjd->bqhd', p_sel, v_sel)
                + jnp.einsum('bqhj,bjhd->bqhd', p_own, v_own))

    outs = lax.map(chunk, jnp.arange(S // MOBA_Q_CHUNK))
    return outs.transpose(1, 0, 2, 3, 4).reshape(B, S, H, Dh)


def mla_attention(q_nope, q_rope, k_nope, k_rope, v):
    B, S, H, _ = q_nope.shape
    scale = (MLA_NOPE_DIM + MLA_ROPE_DIM) ** -0.5
    kpos = jnp.arange(S)

    def block(c):
        start = c * MLA_Q_BLOCK
        qn = lax.dynamic_slice_in_dim(q_nope, start, MLA_Q_BLOCK, axis=1)
        qr = lax.dynamic_slice_in_dim(q_rope, start, MLA_Q_BLOCK, axis=1)
        s = (jnp.einsum('bqhd,bkhd->bhqk', qn, k_nope)
             + jnp.einsum('bqhd,bkd->bhqk', qr, k_rope)).astype(jnp.float32) * scale
        qpos = start + jnp.arange(MLA_Q_BLOCK)
        s = jnp.where((kpos[None, :] <= qpos[:, None])[None, None], s, -jnp.inf)
        p = jax.nn.softmax(s, axis=-1).astype(v.dtype)
        return jnp.einsum('bhqk,bkhd->bqhd', p, v)

    outs = lax.map(block, jnp.arange(S // MLA_Q_BLOCK))
    return outs.transpose(1, 0, 2, 3, 4).reshape(B, S, H * MLA_V_DIM)


def setup_inputs(seed: int = 0) -> dict:
    key = jax.random.key(seed)
    ks = jax.random.split(key, 17)

    def dense(k, shape, fan_in):
        return jax.random.normal(k, shape, jnp.float32) * (fan_in ** -0.5)

    def gain(k, shape):
        return 1.0 + 0.02 * jax.random.normal(k, shape, jnp.float32)

    L = DEPTH
    return {
        "x": jax.random.normal(ks[0], (BATCH, SEQ, D_MODEL), jnp.float32),
        "positions": jnp.broadcast_to(jnp.arange(SEQ, dtype=jnp.int32), (BATCH, SEQ)),
        "attn_norm": gain(ks[1], (L, D_MODEL)),
        "w_in": dense(ks[2], (L, D_MODEL, IN_COLS), D_MODEL),
        "q_norm": gain(ks[3], (L, MLA_Q_RANK)),
        "w_uq": dense(ks[4], (L, MLA_Q_RANK, MLA_HEADS * (MLA_NOPE_DIM + MLA_ROPE_DIM)), MLA_Q_RANK),
        "kv_norm": gain(ks[5], (L, MLA_KV_RANK)),
        "w_ukv": dense(ks[6], (L, MLA_KV_RANK, MLA_HEADS * (MLA_NOPE_DIM + MLA_V_DIM)), MLA_KV_RANK),
        "w_branch_a": dense(ks[7], (L, MOBA_WIDTH, D_MODEL), MOBA_WIDTH),
        "w_branch_b": dense(ks[8], (L, MLA_WIDTH, D_MODEL), MLA_WIDTH),
        "w_out": dense(ks[9], (L, D_MODEL, D_MODEL), D_MODEL),
        "ffn_norm": gain(ks[10], (L, D_MODEL)),
        "w_gate": dense(ks[11], (L, D_MODEL, D_FF), D_MODEL),
        "w_up": dense(ks[12], (L, D_MODEL, D_FF), D_MODEL),
        "w_down": dense(ks[13], (L, D_FF, D_MODEL), D_FF),
        "final_norm": gain(ks[14], (D_MODEL,)),
    }


def reference(x, positions, attn_norm, w_in, q_norm, w_uq, kv_norm, w_ukv, w_branch_a, w_branch_b,
              w_out, ffn_norm, w_gate, w_up, w_down, final_norm):
    B, S, _ = x.shape
    split_at = np.cumsum(np.array(IN_SIZES))[:-1].tolist()
    h = x
    for l in range(DEPTH):
        xn = rmsnorm(h, attn_norm[l])
        proj = xn @ w_in[l]
        q_a, k_a, v_a, c_q, c_kv, k_r, gates = jnp.split(proj, split_at, axis=-1)

        q_a = q_a.reshape(B, S, MOBA_HEADS, MOBA_HEAD_DIM)
        k_a = k_a.reshape(B, S, MOBA_HEADS, MOBA_HEAD_DIM)
        v_a = v_a.reshape(B, S, MOBA_HEADS, MOBA_HEAD_DIM)
        q_a = jnp.concatenate([rope(q_a[..., :PARTIAL_ROPE_DIM], positions), q_a[..., PARTIAL_ROPE_DIM:]], axis=-1)
        k_a = jnp.concatenate([rope(k_a[..., :PARTIAL_ROPE_DIM], positions), k_a[..., PARTIAL_ROPE_DIM:]], axis=-1)
        y_a = moba_attention(q_a, k_a, v_a).reshape(B, S, MOBA_WIDTH)

        qh = (rmsnorm(c_q, q_norm[l]) @ w_uq[l]).reshape(B, S, MLA_HEADS, MLA_NOPE_DIM + MLA_ROPE_DIM)
        q_nope, q_rope = qh[..., :MLA_NOPE_DIM], rope(qh[..., MLA_NOPE_DIM:], positions)
        kv = (rmsnorm(c_kv, kv_norm[l]) @ w_ukv[l]).reshape(B, S, MLA_HEADS, MLA_NOPE_DIM + MLA_V_DIM)
        k_nope, v_b = kv[..., :MLA_NOPE_DIM], kv[..., MLA_NOPE_DIM:]
        k_rope = rope(k_r[:, :, None, :], positions)[:, :, 0, :]
        y_b = mla_attention(q_nope, q_rope, k_nope, k_rope, v_b)

        g = jax.nn.sigmoid(gates.astype(jnp.float32)).astype(x.dtype)
        g_a, g_b = g[..., :D_MODEL], g[..., D_MODEL:]
        mixed = g_a * (y_a @ w_branch_a[l]) + g_b * (y_b @ w_branch_b[l])
        h = h + mixed @ w_out[l]

        hn = rmsnorm(h, ffn_norm[l])
        h = h + (jax.nn.silu(hn @ w_gate[l]) * (hn @ w_up[l])) @ w_down[l]
    return rmsnorm(h, final_norm)
```

```cpp
#include <hip/hip_runtime.h>
#include <hip/hip_cooperative_groups.h>
#include <cstdio>
#include <cstdint>
#include <cmath>
namespace cg = cooperative_groups;
namespace pg8 {
#define PG8_LAS __attribute__((address_space(3)))
typedef unsigned short bf16_t;
typedef short bf16x8 __attribute__((ext_vector_type(8)));
typedef float f32x4 __attribute__((ext_vector_type(4)));
typedef unsigned u32x4 __attribute__((ext_vector_type(4)));
constexpr int BM = 256, BK = 64, HALF = 128, HTB = HALF * BK * 2  , STAGE_BYTES = 8 * HTB, NXCD = 8, WGM = 8;

__host__ __device__ __forceinline__ int lds_byte(int r, int c) { const int st = (r >> 4) * 2 + (c >> 5), rr = r & 15, cc = c & 31, ob = rr * 64 + cc * 2; return st * 1024 + (ob ^ (((ob >> 9) & 1) << 5)); }
__host__ __device__ __forceinline__ void stage_rc(int b, int& R, int& C) { const int st = b / 1024, sb = b % 1024, swz = sb ^ (((sb >> 9) & 1) << 5); R = (st >> 1) * 16 + swz / 64; C = (st & 1) * 32 + (swz % 64) / 2; }
__host__ __device__ __forceinline__ int perm32(int rho) { const int n = rho >> 4, i = rho & 15; return 8 * (i >> 2) + 4 * n + (i & 3); }

struct Unit { int pm, pn; };
struct Gemm { const bf16_t* A; const bf16_t* Bt; int M, N, K; };

struct StaticOrder {
    int nM, nN, nwg, G, c;
    __host__ __device__ void init(int M, int N, int G_, int c_) { nM = M / BM; nN = N / BM; nwg = nM * nN; G = G_; c = c_; }
    __host__ __device__ bool next(int i, Unit& u) const {
        const long L = (long)i * G + c; if (L >= nwg) return false;
        int wgid = (int)L; { const int q = nwg / NXCD, r = nwg % NXCD, xcd = wgid % NXCD, off = wgid / NXCD; wgid = (xcd < r ? xcd * (q + 1) : r * (q + 1) + (xcd - r) * q) + off; }
        const int nig = WGM * nN, gid = wgid / nig, fm = gid * WGM, gsz = (nM - fm) < WGM ? (nM - fm) : WGM;
        u.pm = fm + ((wgid % nig) % gsz); u.pn = (wgid % nig) / gsz; return true;
    }
    __device__ __forceinline__ void a_ready(const Unit&) const {}
    __device__ __forceinline__ void done(const Unit&) const {}
};
typedef __bf16 bf16x2_n __attribute__((ext_vector_type(2)));
__device__ __forceinline__ unsigned cvt_pk_bf16(float lo, float hi) { bf16x2_n v = {(__bf16)lo, (__bf16)hi}; return __builtin_bit_cast(unsigned, v); }
typedef float f32x2 __attribute__((ext_vector_type(2)));
template <class Epi, class Sched, bool STAMP = false>
__device__ __forceinline__ void gemm_phase(PG8_LAS unsigned char* lds, const Gemm g, const Sched& S, const Epi& E, unsigned long long* stamps) {
    const int tid = threadIdx.x, wid = __builtin_amdgcn_readfirstlane(tid >> 6), lane = tid & 63, wr = wid >> 2, wc = wid & 3, fr = lane & 15, fq = lane >> 4;
    const int K = g.K, nt = K / BK;
    int ts_lo = 0, ts_hi = 0, nts = 0; const unsigned long long rt_entry = STAMP ? (unsigned long long)wall_clock64() : 0ull;
#define PG8_STAMP() do { if (STAMP && wid == 0 && nts < 64) { const unsigned long long _c = (unsigned long long)clock64(); \
        ts_lo = (lane == nts) ? (int)(unsigned)_c : ts_lo; ts_hi = (lane == nts) ? (int)(unsigned)(_c >> 32) : ts_hi; ++nts; } } while (0)
    PG8_STAMP();
    unsigned voffA[2], voffB[2];
#pragma unroll
    for (int i = 0; i < 2; ++i) { int R, C; stage_rc(tid * 16 + i * 8192, R, C); const int Rb = Epi::PERM ? ((R & ~31) + perm32(R & 31)) : R;
        voffA[i] = (unsigned)(R * K + C) * 2u; voffB[i] = (unsigned)(Rb * K + C) * 2u; }
    const size_t kstep = (size_t)(BK * 2);
    const size_t hstep = (size_t)HALF * K * 2;
    const size_t tstep = 2 * hstep;
    const unsigned ldsw = (unsigned)wid * 1024u;
    const int aoff = lds_byte(wr * 64 + fr, fq * 8), boff = lds_byte(wc * 32 + fr, fq * 8);
#define PG8_SA(b, h) (((b) * 2 + (h)) * HTB)
#define PG8_SB(b, h) ((4 + (b) * 2 + (h)) * HTB)
#define PG8_STAGE(bufoff, gbase, voff) do { _Pragma("unroll") for (int _i = 0; _i < 2; ++_i) \
        __builtin_amdgcn_global_load_lds((const unsigned*)((const char*)(gbase) + (voff)[_i]), (PG8_LAS unsigned*)(lds + (bufoff) + ldsw + _i * 8192), 16, 0, 0); } while (0)
#define PG8_LDA(dst, b, h) do { _Pragma("unroll") for (int m = 0; m < 4; ++m) _Pragma("unroll") for (int k = 0; k < 2; ++k) dst[m][k] = *(const PG8_LAS bf16x8*)(lds + PG8_SA(b, h) + aoff + m * 2048 + k * 1024); } while (0)
#define PG8_LDB(dst, b, h) do { _Pragma("unroll") for (int n = 0; n < 2; ++n) _Pragma("unroll") for (int k = 0; k < 2; ++k) dst[n][k] = *(const PG8_LAS bf16x8*)(lds + PG8_SB(b, h) + boff + n * 2048 + k * 1024); } while (0)
#define PG8_MMA(ai, bj, At, Bt) do { __builtin_amdgcn_s_setprio(1); _Pragma("unroll") for (int m = 0; m < 4; ++m) _Pragma("unroll") for (int n = 0; n < 2; ++n) _Pragma("unroll") for (int k = 0; k < 2; ++k) \
        acc[ai][bj][m][n] = __builtin_amdgcn_mfma_f32_16x16x32_bf16(Bt[n][k], At[m][k], acc[ai][bj][m][n], 0, 0, 0); __builtin_amdgcn_s_setprio(0); } while (0)
#define PG8_WAIT_V(n) asm volatile("s_waitcnt vmcnt(" #n ")" ::: "memory")
#define PG8_WAIT_L(n) asm volatile("s_waitcnt lgkmcnt(" #n ")" ::: "memory")
#define PG8_BAR __builtin_amdgcn_s_barrier()
#define PG8_SCHED __builtin_amdgcn_sched_barrier(0)
    Unit cur, nxt; int ui = 0;
    if (!S.next(0, cur)) return;
    f32x4 acc[2][2][4][2];
#pragma unroll
    for (int a = 0; a < 2; ++a)
#pragma unroll
        for (int b = 0; b < 2; ++b)
#pragma unroll
            for (int m = 0; m < 4; ++m)
#pragma unroll
                for (int n = 0; n < 2; ++n) acc[a][b][m][n] = (f32x4){0.f, 0.f, 0.f, 0.f};
    bf16x8 At[4][2], B0[2][2], B1[2][2];
    const char* cA = (const char*)g.A + (size_t)cur.pm * tstep; const char* cB = (const char*)g.Bt + (size_t)cur.pn * tstep;
    S.a_ready(cur);
    PG8_STAGE(PG8_SB(0, 0), cB, voffB); PG8_STAGE(PG8_SA(0, 0), cA, voffA); PG8_STAGE(PG8_SB(0, 1), cB + hstep, voffB); PG8_STAGE(PG8_SA(0, 1), cA + hstep, voffA);
    if (wr == 1) PG8_BAR;
    PG8_WAIT_V(4); PG8_BAR;
    PG8_STAGE(PG8_SB(1, 0), cB + kstep, voffB); PG8_STAGE(PG8_SA(1, 0), cA + kstep, voffA); PG8_STAGE(PG8_SB(1, 1), cB + hstep + kstep, voffB);
    PG8_WAIT_V(6); PG8_BAR;
    PG8_STAMP();
    for (;;) {
        const bool has_next = S.next(ui + 1, nxt);
        const char* nA = has_next ? (const char*)g.A + (size_t)nxt.pm * tstep : cA; const char* nB = has_next ? (const char*)g.Bt + (size_t)nxt.pn * tstep : cB;
        for (int t = 0; t < nt; t += 2) {
            const bool last = (t == nt - 2);
            const char* a1 = cA + (size_t)(t + 1) * kstep;
            const char* a2 = last ? nA : cA + (size_t)(t + 2) * kstep; const char* b2 = last ? nB : cB + (size_t)(t + 2) * kstep;
            const char* a3 = a2 + kstep; const char* b3 = b2 + kstep;
            if (last && has_next) S.a_ready(nxt);
            PG8_LDB(B0, 0, 0); PG8_SCHED; PG8_LDA(At, 0, 0); PG8_STAGE(PG8_SA(1, 1), a1 + hstep, voffA);
            PG8_WAIT_L(8); PG8_BAR; PG8_WAIT_L(0); PG8_MMA(0, 0, At, B0); PG8_BAR; PG8_SCHED;
            PG8_LDB(B1, 0, 1); PG8_STAGE(PG8_SB(0, 0), b2, voffB);
            PG8_BAR; PG8_WAIT_L(0); PG8_MMA(0, 1, At, B1); PG8_BAR;
            PG8_LDA(At, 0, 1); PG8_STAGE(PG8_SA(0, 0), a2, voffA);
            PG8_BAR; PG8_WAIT_L(0); PG8_MMA(1, 0, At, B0); PG8_BAR; PG8_SCHED;
            PG8_STAGE(PG8_SB(0, 1), b2 + hstep, voffB);
            PG8_WAIT_V(6); PG8_BAR; PG8_MMA(1, 1, At, B1); PG8_BAR;
            PG8_LDB(B0, 1, 0); PG8_SCHED; PG8_LDA(At, 1, 0); PG8_STAGE(PG8_SA(0, 1), a2 + hstep, voffA);
            PG8_WAIT_L(8); PG8_BAR; PG8_WAIT_L(0); PG8_MMA(0, 0, At, B0); PG8_BAR; PG8_SCHED;
            PG8_LDB(B1, 1, 1); PG8_STAGE(PG8_SB(1, 0), b3, voffB);
            PG8_BAR; PG8_WAIT_L(0); PG8_MMA(0, 1, At, B1); PG8_BAR;
            PG8_LDA(At, 1, 1); PG8_STAGE(PG8_SA(1, 0), a3, voffA);
            PG8_BAR; PG8_WAIT_L(0); PG8_MMA(1, 0, At, B0); PG8_BAR; PG8_SCHED;
            PG8_STAGE(PG8_SB(1, 1), b3 + hstep, voffB);
            PG8_WAIT_V(6); PG8_BAR; PG8_MMA(1, 1, At, B1); PG8_BAR;
        }
        PG8_STAMP();
        if constexpr (!Epi::AFTER_DRAIN) { E(acc, cur, wr, wc, fr, fq); S.done(cur); }
        PG8_STAMP();
        if (!has_next) break;
#pragma unroll
        for (int a = 0; a < 2; ++a)
#pragma unroll
            for (int b = 0; b < 2; ++b)
#pragma unroll
                for (int m = 0; m < 4; ++m)
#pragma unroll
                    for (int n = 0; n < 2; ++n) acc[a][b][m][n] = (f32x4){0.f, 0.f, 0.f, 0.f};
        cur = nxt; cA = nA; cB = nB; ++ui;
    }
    PG8_WAIT_V(0);
    if (wr == 0) PG8_BAR;
    PG8_BAR;
    if constexpr (Epi::AFTER_DRAIN) { E.fused(acc, cur, wr, wc, fr, fq, lds, wid, lane); S.done(cur); }
    PG8_STAMP();
    if (STAMP && wid == 0) { stamps[lane] = lane < nts ? (((unsigned long long)(unsigned)ts_hi << 32) | (unsigned)ts_lo) : 0ull;
        if (lane == 62) stamps[62] = rt_entry; if (lane == 63) stamps[63] = (unsigned long long)wall_clock64(); }
#undef PG8_STAMP
#undef PG8_SA
#undef PG8_SB
#undef PG8_STAGE
#undef PG8_LDA
#undef PG8_LDB
#undef PG8_MMA
#undef PG8_WAIT_V
#undef PG8_WAIT_L
#undef PG8_BAR
#undef PG8_SCHED
}
}

using pg8::bf16_t; using pg8::bf16x8; using pg8::f32x4; using pg8::u32x4; using pg8::Unit; using pg8::cvt_pk_bf16;
typedef short s16x4 __attribute__((ext_vector_type(4)));
typedef float f32x16 __attribute__((ext_vector_type(16)));
typedef unsigned long long u64;
constexpr int S_ = 16384, DM = 2048, DFF = 5632;
constexpr float EPS_ = 1e-6f;
constexpr size_t MiB = (size_t)1 << 20;
constexpr size_t WS_WIN = 0, WS_WUQ = 32 * MiB, WS_WUKV = WS_WUQ + 3 * MiB / 2, WS_WBR = WS_WUKV + MiB, WS_WOUT = WS_WBR + 8 * MiB, WS_WGU = WS_WOUT + 8 * MiB,
                 WS_WDN = WS_WGU + 44 * MiB, WS_CSA = WS_WDN + 22 * MiB, WS_CSB = WS_CSA + 2 * MiB, WS_SEL = WS_CSB + 4 * MiB, WS_KMS = WS_SEL + MiB,
                 WS_SSQ = WS_KMS + MiB / 4, WS_CTL = WS_SSQ + MiB / 4, WS_ACT = 128 * MiB, WS_END = 512 * MiB;
static_assert(WS_CTL + 4096 <= WS_ACT, "ws map");
constexpr size_t A_XN = 0, A_QA = 64 * MiB, A_KA = 96 * MiB, A_VA = 128 * MiB, A_CQ = 160 * MiB, A_CKV = 176 * MiB, A_KRP = 184 * MiB,
                 A_QN = 0, A_KN = 32 * MiB, A_VB = 192 * MiB, A_QRP = 224 * MiB, A_Y = 240 * MiB, A_T = 0, A_MIX = 128 * MiB,
                 A_HF = 256 * MiB, A_HB = 0, A_ACTV = 64 * MiB;

struct Params {
    const float* x; const int* pos; const float* attn_norm; const float* w_in; const float* q_norm; const float* w_uq; const float* kv_norm; const float* w_ukv;
    const float* w_ba; const float* w_bb; const float* w_out; const float* ffn_norm; const float* w_gate; const float* w_up; const float* w_down; const float* final_norm;
    float* out; unsigned char* ws;
    float invf_a[16]; float invf_b[32];
    int ph_lo, ph_hi;
};

__device__ __forceinline__ float bflo(unsigned u) { return __uint_as_float(u << 16); }
__device__ __forceinline__ float bfhi(unsigned u) { return __uint_as_float(u & 0xffff0000u); }
__device__ __forceinline__ void st8(bf16_t* p, f32x4 a, f32x4 b) {
    u32x4 w; w.x = cvt_pk_bf16(a[0], a[1]); w.y = cvt_pk_bf16(a[2], a[3]); w.z = cvt_pk_bf16(b[0], b[1]); w.w = cvt_pk_bf16(b[2], b[3]); *(u32x4*)p = w; }
__device__ __forceinline__ void rot4(f32x4& v, const f32x4 t) {
    const float a0 = v[0] * t[0] - v[1] * t[1], a1 = v[1] * t[0] + v[0] * t[1], b0 = v[2] * t[2] - v[3] * t[3], b1 = v[3] * t[2] + v[2] * t[3];
    v[0] = a0; v[1] = a1; v[2] = b0; v[3] = b1; }
__device__ __forceinline__ float sigm(float x) { return __builtin_amdgcn_rcpf(1.0f + __expf(-x)); }
__device__ __forceinline__ float sq4(const f32x4 v) { return (v[0] * v[0] + v[1] * v[1]) + (v[2] * v[2] + v[3] * v[3]); }
__device__ __forceinline__ float rstd_of(float ssq, float inv_n) { return 1.0f / sqrtf(ssq * inv_n + EPS_); }

struct EpiProj {
    static constexpr bool PERM = true, AFTER_DRAIN = false;
    bf16_t *qa, *ka, *va, *cq, *ckv, *krp, *gates; const float* csa; const float* csb; float *kms, *ssq_q, *ssq_kv;
    __device__ __forceinline__ void operator()(const f32x4 (&acc)[2][2][4][2], const Unit& u, int wr, int wc, int fr, int fq) const {
        const int pn = u.pn, row0 = u.pm * 256 + wr * 64 + fr, cl = wc * 32 + 8 * fq;
        if (pn < 8) {
            bf16_t* dst = pn < 4 ? qa : ka; const bool isk = pn >= 4; const int hb = (pn & 3) * 256;
            float ks[2][8];
#pragma unroll
            for (int b = 0; b < 2; ++b)
#pragma unroll
                for (int i = 0; i < 8; ++i) ks[b][i] = 0.f;
#pragma unroll
            for (int ai = 0; ai < 2; ++ai)
#pragma unroll
                for (int m = 0; m < 4; ++m) { const int row = row0 + ai * 128 + m * 16;
                    f32x4 t0 = {1.f, 0.f, 1.f, 0.f}, t1 = {1.f, 0.f, 1.f, 0.f};
                    if (wc == 0) { const f32x4* tp = (const f32x4*)(csa + (size_t)row * 32 + 8 * fq); t0 = tp[0]; t1 = tp[1]; }
#pragma unroll
                    for (int bj = 0; bj < 2; ++bj) { f32x4 v0 = acc[ai][bj][m][0], v1 = acc[ai][bj][m][1];
                        if (wc == 0) { rot4(v0, t0); rot4(v1, t1); }
                        if (isk) {
#pragma unroll
                            for (int i = 0; i < 4; ++i) { ks[bj][i] += v0[i]; ks[bj][4 + i] += v1[i]; } }
                        st8(dst + (size_t)row * 1024 + hb + bj * 128 + cl, v0, v1); } }
            if (isk) {
#pragma unroll
                for (int bj = 0; bj < 2; ++bj)
#pragma unroll
                    for (int i = 0; i < 8; ++i) { float s = ks[bj][i]; s += __shfl_xor(s, 1); s += __shfl_xor(s, 2); s += __shfl_xor(s, 4); s += __shfl_xor(s, 8);
                        if (fr == 0) atomicAdd(kms + ((size_t)((pn & 3) * 2 + bj) * 64 + u.pm) * 128 + cl + i, s); } }
        } else if (pn < 12) {
#pragma unroll
            for (int ai = 0; ai < 2; ++ai)
#pragma unroll
                for (int m = 0; m < 4; ++m) { const int row = row0 + ai * 128 + m * 16;
#pragma unroll
                    for (int bj = 0; bj < 2; ++bj) st8(va + (size_t)row * 1024 + (pn - 8) * 256 + bj * 128 + cl, acc[ai][bj][m][0], acc[ai][bj][m][1]); }
        } else if (pn < 15) {
            const bool isq = pn < 14; bf16_t* dst = isq ? cq : ckv; const int ld = isq ? 512 : 256, cb = isq ? (pn - 12) * 256 : 0; float* ssq = isq ? ssq_q : ssq_kv;
#pragma unroll
            for (int ai = 0; ai < 2; ++ai)
#pragma unroll
                for (int m = 0; m < 4; ++m) { const int row = row0 + ai * 128 + m * 16; float s = 0.f;
#pragma unroll
                    for (int bj = 0; bj < 2; ++bj) { s += sq4(acc[ai][bj][m][0]) + sq4(acc[ai][bj][m][1]); st8(dst + (size_t)row * ld + cb + bj * 128 + cl, acc[ai][bj][m][0], acc[ai][bj][m][1]); }
                    s += __shfl_xor(s, 16); s += __shfl_xor(s, 32);
                    if (fq == 0) atomicAdd(ssq + row, s); }
        } else if (pn == 15) {
            if (wc < 2) {
#pragma unroll
                for (int ai = 0; ai < 2; ++ai)
#pragma unroll
                    for (int m = 0; m < 4; ++m) { const int row = row0 + ai * 128 + m * 16;
                        const f32x4* tp = (const f32x4*)(csb + (size_t)row * 64 + 32 * wc + 8 * fq); f32x4 v0 = acc[ai][0][m][0], v1 = acc[ai][0][m][1];
                        rot4(v0, tp[0]); rot4(v1, tp[1]); st8(krp + (size_t)row * 64 + cl, v0, v1); } }
        } else {
#pragma unroll
            for (int ai = 0; ai < 2; ++ai)
#pragma unroll
                for (int m = 0; m < 4; ++m) { const int row = row0 + ai * 128 + m * 16;
#pragma unroll
                    for (int bj = 0; bj < 2; ++bj) { f32x4 v0 = acc[ai][bj][m][0], v1 = acc[ai][bj][m][1];
#pragma unroll
                        for (int i = 0; i < 4; ++i) { v0[i] = sigm(v0[i]); v1[i] = sigm(v1[i]); }
                        st8(gates + (size_t)row * 4096 + (pn - 16) * 256 + bj * 128 + cl, v0, v1); } }
        }
    }
};
struct EpiQ {
    static constexpr bool PERM = true, AFTER_DRAIN = false;
    bf16_t *qn, *qrp; const float* csb; const float* ssq_q;
    __device__ __forceinline__ void operator()(const f32x4 (&acc)[2][2][4][2], const Unit& u, int wr, int wc, int fr, int fq) const {
        const int pn = u.pn, row0 = u.pm * 256 + wr * 64 + fr, cl = wc * 32 + 8 * fq;
#pragma unroll
        for (int ai = 0; ai < 2; ++ai)
#pragma unroll
            for (int m = 0; m < 4; ++m) { const int row = row0 + ai * 128 + m * 16; const float r = rstd_of(ssq_q[row], 1.0f / 512.0f);
                if (pn < 4) {
#pragma unroll
                    for (int bj = 0; bj < 2; ++bj) st8(qn + (size_t)row * 1024 + pn * 256 + bj * 128 + cl, acc[ai][bj][m][0] * r, acc[ai][bj][m][1] * r);
                } else { const f32x4* tp = (const f32x4*)(csb + (size_t)row * 64 + 32 * (wc & 1) + 8 * fq); const f32x4 t0 = tp[0], t1 = tp[1];
#pragma unroll
                    for (int bj = 0; bj < 2; ++bj) { f32x4 v0 = acc[ai][bj][m][0] * r, v1 = acc[ai][bj][m][1] * r; rot4(v0, t0); rot4(v1, t1);
                        st8(qrp + (size_t)row * 512 + (pn - 4) * 256 + bj * 128 + cl, v0, v1); } } }
    }
};
struct EpiKV {
    static constexpr bool PERM = true, AFTER_DRAIN = false;
    bf16_t *kn, *vb; const float* ssq_kv;
    __device__ __forceinline__ void operator()(const f32x4 (&acc)[2][2][4][2], const Unit& u, int wr, int wc, int fr, int fq) const {
        const int pn = u.pn, row0 = u.pm * 256 + wr * 64 + fr, cl = wc * 32 + 8 * fq;
#pragma unroll
        for (int ai = 0; ai < 2; ++ai)
#pragma unroll
            for (int m = 0; m < 4; ++m) { const int row = row0 + ai * 128 + m * 16; const float r = rstd_of(ssq_kv[row], 1.0f / 256.0f);
                st8(kn + (size_t)row * 1024 + pn * 128 + cl, acc[ai][0][m][0] * r, acc[ai][0][m][1] * r);
                st8(vb + (size_t)row * 1024 + pn * 128 + cl, acc[ai][1][m][0] * r, acc[ai][1][m][1] * r);
                asm volatile("" ::: "memory"); }
    }
};
struct EpiBranch {
    static constexpr bool PERM = true, AFTER_DRAIN = false;
    const bf16_t* gates; float* T; bf16_t* mixed;
    __device__ __forceinline__ void operator()(const f32x4 (&acc)[2][2][4][2], const Unit& u, int wr, int wc, int fr, int fq) const {
        const bool isb = u.pm >= 64; const int pm = isb ? u.pm - 64 : u.pm, pn = isb ? u.pn - 8 : u.pn;
        const int row0 = pm * 256 + wr * 64 + fr, cl = wc * 32 + 8 * fq;
#pragma unroll
        for (int ai = 0; ai < 2; ++ai)
#pragma unroll
            for (int m = 0; m < 4; ++m) { const int row = row0 + ai * 128 + m * 16;
#pragma unroll
                for (int bj = 0; bj < 2; ++bj) { const int col = pn * 256 + bj * 128 + cl;
                    const u32x4 gw = *(const u32x4*)(gates + (size_t)row * 4096 + (isb ? 2048 : 0) + col);
                    const f32x4 g0 = {bflo(gw.x), bfhi(gw.x), bflo(gw.y), bfhi(gw.y)}, g1 = {bflo(gw.z), bfhi(gw.z), bflo(gw.w), bfhi(gw.w)};
                    float* tp = T + (size_t)row * 2048 + col;
#ifdef PROBE_DROP_A
                    if (!isb) { *(f32x4*)tp = (f32x4){0.f, 0.f, 0.f, 0.f}; *(f32x4*)(tp + 4) = (f32x4){0.f, 0.f, 0.f, 0.f}; }
#else
                    if (!isb) { *(f32x4*)tp = g0 * acc[ai][bj][m][0]; *(f32x4*)(tp + 4) = g1 * acc[ai][bj][m][1]; }
#endif
                    else { const f32x4 a0 = *(const f32x4*)tp, a1 = *(const f32x4*)(tp + 4);
#ifdef PROBE_DROP_B
                        st8(mixed + (size_t)row * 2048 + col, a0, a1); } } }
#else
                        st8(mixed + (size_t)row * 2048 + col, a0 + g0 * acc[ai][bj][m][0], a1 + g1 * acc[ai][bj][m][1]); } } }
#endif
    }
};
struct BranchOrder {
    pg8::StaticOrder so;
    __device__ void init(int G, int c) { so.init(S_, DM, G, c); }
    __device__ bool next(int i, Unit& u) const { if (!so.next(i >> 1, u)) return false; if (i & 1) { u.pm += 64; u.pn += 8; } return true; }
    __device__ __forceinline__ void a_ready(const Unit&) const {}
    __device__ __forceinline__ void done(const Unit&) const {}
};
struct EpiOut {
    static constexpr bool PERM = true, AFTER_DRAIN = false;
    const float* x; float* hf; bf16_t* hb; float* ssq_h;
    __device__ __forceinline__ void operator()(const f32x4 (&acc)[2][2][4][2], const Unit& u, int wr, int wc, int fr, int fq) const {
        const int pn = u.pn, row0 = u.pm * 256 + wr * 64 + fr, cl = wc * 32 + 8 * fq;
#pragma unroll
        for (int ai = 0; ai < 2; ++ai)
#pragma unroll
            for (int m = 0; m < 4; ++m) { const int row = row0 + ai * 128 + m * 16; float s = 0.f;
#pragma unroll
                for (int bj = 0; bj < 2; ++bj) { const size_t o = (size_t)row * 2048 + pn * 256 + bj * 128 + cl;
                    const f32x4 h0 = *(const f32x4*)(x + o) + acc[ai][bj][m][0], h1 = *(const f32x4*)(x + o + 4) + acc[ai][bj][m][1];
                    *(f32x4*)(hf + o) = h0; *(f32x4*)(hf + o + 4) = h1; st8(hb + o, h0, h1); s += sq4(h0) + sq4(h1); }
                s += __shfl_xor(s, 16); s += __shfl_xor(s, 32);
                if (fq == 0) atomicAdd(ssq_h + row, s); }
    }
};
struct EpiGU {
    static constexpr bool PERM = true, AFTER_DRAIN = false;
    bf16_t* act; const float* ssq_h;
    __device__ __forceinline__ void operator()(const f32x4 (&acc)[2][2][4][2], const Unit& u, int wr, int wc, int fr, int fq) const {
        const int pn = u.pn, row0 = u.pm * 256 + wr * 64 + fr, cl = wc * 32 + 8 * fq;
#pragma unroll
        for (int ai = 0; ai < 2; ++ai)
#pragma unroll
            for (int m = 0; m < 4; ++m) { const int row = row0 + ai * 128 + m * 16; const float r = rstd_of(ssq_h[row], 1.0f / 2048.0f);
                f32x4 o0, o1;
#pragma unroll
                for (int i = 0; i < 4; ++i) { const float g0 = acc[ai][0][m][0][i] * r, g1 = acc[ai][0][m][1][i] * r;
                    o0[i] = g0 * sigm(g0) * (acc[ai][1][m][0][i] * r); o1[i] = g1 * sigm(g1) * (acc[ai][1][m][1][i] * r); }
                st8(act + (size_t)row * DFF + pn * 128 + cl, o0, o1); }
    }
};
struct EpiDown {
    static constexpr bool PERM = true, AFTER_DRAIN = false;
    const float* hf; float* out; float* ssq_o;
    __device__ __forceinline__ void operator()(const f32x4 (&acc)[2][2][4][2], const Unit& u, int wr, int wc, int fr, int fq) const {
        const int pn = u.pn, row0 = u.pm * 256 + wr * 64 + fr, cl = wc * 32 + 8 * fq;
#pragma unroll
        for (int ai = 0; ai < 2; ++ai)
#pragma unroll
            for (int m = 0; m < 4; ++m) { const int row = row0 + ai * 128 + m * 16; float s = 0.f;
#pragma unroll
                for (int bj = 0; bj < 2; ++bj) { const size_t o = (size_t)row * 2048 + pn * 256 + bj * 128 + cl;
                    const f32x4 h0 = *(const f32x4*)(hf + o) + acc[ai][bj][m][0], h1 = *(const f32x4*)(hf + o + 4) + acc[ai][bj][m][1];
                    *(f32x4*)(out + o) = h0; *(f32x4*)(out + o + 4) = h1; s += sq4(h0) + sq4(h1); }
                s += __shfl_xor(s, 16); s += __shfl_xor(s, 32);
                if (fq == 0) atomicAdd(ssq_o + row, s); }
    }
};

namespace att {
constexpr int SHM_V = 16384, SHM_K = 16384, SHM_K2 = 8192;
constexpr int OFF_K = 0, OFF_K2 = 2 * SHM_K, OFF_V = OFF_K2 + 2 * SHM_K2, OFF_WS = OFF_V + 2 * SHM_V, OFF_MISC = OFF_WS + 8 * 64 * 4, OFF_Q2 = OFF_MISC + 1024;
#define KSWZ(row, colB) ((row) * 256 + ((colB) ^ (((row) & 7) << 4)))
#define K2SWZ(row, colB) ((row) * 128 + ((colB) ^ (((row) & 7) << 4)))
#define SBAR() __builtin_amdgcn_sched_barrier(0)
__device__ __forceinline__ int v_st(int k, int c) { const int kk = (k & ~0xC) | ((k & 4) << 1) | ((k & 8) >> 1); return ((kk >> 3) * 4 + (c >> 5)) * 512 + ((kk & 7) * 32 + (c & 31)) * 2; }
__device__ __forceinline__ int v_rd_base(int lane) { return ((lane & 3) << 3) | (((lane >> 2) & 3) << 6) | (((lane >> 4) & 1) << 5) | (((lane >> 5) & 1) << 8); }
constexpr int v_rd_off(int d0, int ks, int half) { return d0 * 512 + ks * 4096 + half * 2048; }
__device__ __forceinline__ int crow(int r, int hi) { return (r & 3) + 8 * (r >> 2) + 4 * hi; }
__device__ __forceinline__ unsigned cvtpk(float lo, float hi) { unsigned r; asm volatile("v_cvt_pk_bf16_f32 %0, %1, %2" : "=v"(r) : "v"(lo), "v"(hi)); return r; }
__device__ __forceinline__ void mask_tile(f32x16& p0, f32x16& p1, int dq) {
    const float NEG = -__builtin_inff();
#pragma unroll
    for (int r = 0; r < 16; ++r) { const int c = (r & 3) + 8 * (r >> 2);
        if (dq - c < 0) p0[r] = NEG;
        if (dq - c - 32 < 0) p1[r] = NEG; }
}
__device__ __forceinline__ void partialSM(f32x16& p0, f32x16& p1, float& m_reg, float& mn, float& alpha, const float C2) {
    float pmax = p0[0];
#pragma unroll
    for (int r = 1; r < 16; ++r) pmax = fmaxf(pmax, p0[r]);
#pragma unroll
    for (int r = 0; r < 16; ++r) pmax = fmaxf(pmax, p1[r]);
    { auto rr = __builtin_amdgcn_permlane32_swap(__float_as_uint(pmax), __float_as_uint(pmax), false, false);
      pmax = fmaxf(__uint_as_float(rr[0]), __uint_as_float(rr[1])); }
    if (__builtin_expect(__all((pmax - m_reg) * C2 <= 11.5f), 1)) { mn = m_reg; alpha = 1.f; }
    else { mn = fmaxf(m_reg, pmax); alpha = __builtin_amdgcn_exp2f((m_reg - mn) * C2); m_reg = mn; }
    const float mnL = -mn * C2;
#pragma unroll
    for (int r = 0; r < 16; ++r) p0[r] = fmaf(p0[r], C2, mnL);
#pragma unroll
    for (int r = 0; r < 16; ++r) p1[r] = fmaf(p1[r], C2, mnL);
#pragma unroll
    for (int r = 0; r < 16; ++r) p0[r] = __builtin_amdgcn_exp2f(p0[r]);
}
__device__ __forceinline__ void finishSM(f32x16& p0, f32x16& p1, float alpha, float& l_reg, bf16x8& pa0, bf16x8& pa1, bf16x8& pa2, bf16x8& pa3) {
#pragma unroll
    for (int r = 0; r < 16; ++r) p1[r] = __builtin_amdgcn_exp2f(p1[r]);
    float ps = 0;
#pragma unroll
    for (int r = 0; r < 16; ++r) ps += p0[r];
#pragma unroll
    for (int r = 0; r < 16; ++r) ps += p1[r];
    { auto rr = __builtin_amdgcn_permlane32_swap(__float_as_uint(ps), __float_as_uint(ps), false, false);
      ps = __uint_as_float(rr[0]) + __uint_as_float(rr[1]); }
    l_reg = l_reg * alpha + ps;
#define PK4(P, B_, OUT) do { unsigned a0 = cvtpk(P[B_+0], P[B_+1]), a1 = cvtpk(P[B_+2], P[B_+3]);                          \
        unsigned b0 = cvtpk(P[B_+4], P[B_+5]), b1 = cvtpk(P[B_+6], P[B_+7]);                                             \
        auto r0 = __builtin_amdgcn_permlane32_swap(a0, b0, false, false); auto r1 = __builtin_amdgcn_permlane32_swap(a1, b1, false, false); \
        u32x4 w = {r0[0], r1[0], r0[1], r1[1]}; OUT = *reinterpret_cast<bf16x8*>(&w); } while (0)
    PK4(p0, 0, pa0); PK4(p0, 8, pa1); PK4(p1, 0, pa2); PK4(p1, 8, pa3);
#undef PK4
}
template <int KB, bool MLA>
__device__ __forceinline__ void qkt(f32x16& p0, f32x16& p1, const char* lds, int r32, int hi, const bf16x8* qr, const char* q2p) {
    p0 = f32x16{}; p1 = f32x16{};
    const char* kb[4];
#pragma unroll
    for (int dd = 0; dd < 4; ++dd) kb[dd] = lds + OFF_K + KB * SHM_K + KSWZ(r32, (dd * 16 + hi * 8) * 2);
#pragma unroll
    for (int d0 = 0; d0 < 8; ++d0) { const char* a = kb[d0 & 3] + (d0 >> 2) * 128;
        bf16x8 b0 = *reinterpret_cast<const bf16x8*>(a);
        bf16x8 b1 = *reinterpret_cast<const bf16x8*>(a + 32 * 256);
        p0 = __builtin_amdgcn_mfma_f32_32x32x16_bf16(b0, qr[d0], p0, 0, 0, 0);
        p1 = __builtin_amdgcn_mfma_f32_32x32x16_bf16(b1, qr[d0], p1, 0, 0, 0); }
    if constexpr (MLA) {
#pragma unroll
        for (int d0 = 0; d0 < 4; ++d0) { const char* a = lds + OFF_K2 + KB * SHM_K2 + K2SWZ(r32, (d0 * 16 + hi * 8) * 2);
            bf16x8 b0 = *reinterpret_cast<const bf16x8*>(a);
            bf16x8 b1 = *reinterpret_cast<const bf16x8*>(a + 32 * 128);
            const bf16x8 qf = *reinterpret_cast<const bf16x8*>(q2p + d0 * 16);
            p0 = __builtin_amdgcn_mfma_f32_32x32x16_bf16(b0, qf, p0, 0, 0, 0);
            p1 = __builtin_amdgcn_mfma_f32_32x32x16_bf16(b1, qf, p1, 0, 0, 0); }
    }
}
template <int VB>
__device__ __forceinline__ void pv_tile(f32x16* o, int vb0, bf16x8 pa0, bf16x8 pa1, bf16x8 pa2, bf16x8 pa3) {
#define TRRD(dst, off) asm volatile("ds_read_b64_tr_b16 %0, %1 offset:%2" : "=&v"(dst) : "v"(vb0), "i"(off) : "memory")
#define PV_D0(d0) do { s16x4 l0, l1, l2, l3, h0, h1, h2, h3; constexpr int b_ = VB * SHM_V + v_rd_off(d0, 0, 0); \
        TRRD(l0, b_); TRRD(h0, b_ + 2048); TRRD(l1, b_ + 4096); TRRD(h1, b_ + 6144); TRRD(l2, b_ + 8192); TRRD(h2, b_ + 10240); TRRD(l3, b_ + 12288); TRRD(h3, b_ + 14336); \
        asm volatile("s_waitcnt lgkmcnt(0)" ::: "memory"); SBAR();   \
        o[d0] = __builtin_amdgcn_mfma_f32_32x32x16_bf16(pa0, (bf16x8){l0[0], l0[1], l0[2], l0[3], h0[0], h0[1], h0[2], h0[3]}, o[d0], 0, 0, 0);   \
        o[d0] = __builtin_amdgcn_mfma_f32_32x32x16_bf16(pa1, (bf16x8){l1[0], l1[1], l1[2], l1[3], h1[0], h1[1], h1[2], h1[3]}, o[d0], 0, 0, 0);   \
        o[d0] = __builtin_amdgcn_mfma_f32_32x32x16_bf16(pa2, (bf16x8){l2[0], l2[1], l2[2], l2[3], h2[0], h2[1], h2[2], h2[3]}, o[d0], 0, 0, 0);   \
        o[d0] = __builtin_amdgcn_mfma_f32_32x32x16_bf16(pa3, (bf16x8){l3[0], l3[1], l3[2], l3[3], h3[0], h3[1], h3[2], h3[3]}, o[d0], 0, 0, 0); } while (0)
    PV_D0(0); PV_D0(1); PV_D0(2); PV_D0(3);
#undef PV_D0
#undef TRRD
}

struct AttnIO { const bf16_t* Q; const bf16_t* Q2; const bf16_t* K; const bf16_t* K2; const bf16_t* V; bf16_t* O; const u64* sel; };

template <bool MLA>
__device__ __forceinline__ void attn_item(char* lds, const AttnIO& io, int h, int qb, float C2) {
    int tid_ = threadIdx.x; asm volatile("" : "+v"(tid_));
    const int tid = tid_, wid = __builtin_amdgcn_readfirstlane(tid >> 6), lane = tid & 63, r32 = lane & 31, hi = lane >> 5;
    const int q0 = qb * 256, qlo = q0 + wid * 32, row = qlo + r32, qm = row - 4 * hi;
    float* wsf = (float*)(lds + OFF_WS) + wid * 64; float* li_l = wsf; float* al_l = wsf + 32;
    u64* wm = (u64*)(lds + OFF_MISC); int* blist = (int*)(lds + OFF_MISC + 64); int* nbl = (int*)(lds + OFF_MISC + 64 + 66 * 4);
    bf16x8 qr[8]; const char* q2p = lds + OFF_Q2 + wid * 4096 + lane * 64;
#pragma unroll
    for (int d0 = 0; d0 < 8; ++d0) qr[d0] = *(const bf16x8*)(io.Q + (size_t)row * 1024 + h * 128 + d0 * 16 + hi * 8);
    if constexpr (MLA) {
#pragma unroll
        for (int d0 = 0; d0 < 4; ++d0) *(bf16x8*)(lds + OFF_Q2 + wid * 4096 + lane * 64 + d0 * 16) = *(const bf16x8*)(io.Q2 + (size_t)row * 512 + h * 64 + d0 * 16 + hi * 8);
    }
    u64 rowmask = 0, wmask = 0; int NT;
    if constexpr (!MLA) {
        rowmask = io.sel[(size_t)row * 8 + h];
        unsigned lo = (unsigned)rowmask, hi32 = (unsigned)(rowmask >> 32);
#pragma unroll
        for (int off = 1; off < 32; off <<= 1) { lo |= __shfl_xor(lo, off); hi32 |= __shfl_xor(hi32, off); }
        lo = __builtin_amdgcn_readfirstlane(lo); hi32 = __builtin_amdgcn_readfirstlane(hi32);
        wmask = ((u64)hi32 << 32) | lo;
        if (lane == 0) wm[wid] = wmask;
        __syncthreads();
        if (tid == 0) { u64 um = 0; for (int w = 0; w < 8; ++w) um |= wm[w];
            if (qb < 64) um &= (qb == 0) ? 0ull : (~0ull >> (64 - qb));
            int n = 0; while (um) { const int j = __builtin_ctzll(um); blist[n++] = j; um &= um - 1; }
            blist[n++] = qb; *nbl = n; }
        __syncthreads();
        NT = 4 * __builtin_amdgcn_readfirstlane(*nbl);
    } else NT = 4 * (qb + 1);
    const int sr = tid >> 4, sc = (tid & 15) * 8, vst0 = v_st(sr, sc), vst1 = v_st(32 + sr, sc), kws = KSWZ(sr, sc * 2);
    const int s2r = tid >> 3, s2c = (tid & 7) * 8, k2ws = K2SWZ(s2r, s2c * 2);
    const int vb0 = (int)(uintptr_t)(lds) + OFF_V + v_rd_base(lane);
    const bf16_t* Kh = io.K + h * 128 + sc; const bf16_t* Vh = io.V + h * 128 + sc; const bf16_t* K2h = MLA ? io.K2 + s2c : nullptr;
    float m_reg = -1e30f, l_reg = 0.f; f32x16 o[4] = {};
    bf16x8 st_k0, st_k1, st_v0, st_v1, st_k2;
#define KEY0(t) (MLA ? (t) * 64 : (__builtin_amdgcn_readfirstlane(blist[(t) >> 2]) * 256 + ((t) & 3) * 64))
#define LOADS_K(k0) do { st_k0 = *(const bf16x8*)(Kh + (size_t)((k0) + sr) * 1024); st_k1 = *(const bf16x8*)(Kh + (size_t)((k0) + 32 + sr) * 1024);      \
                       if constexpr (MLA) st_k2 = *(const bf16x8*)(K2h + (size_t)((k0) + s2r) * 64); } while (0)
#define LOADS_V(k0) do { st_v0 = *(const bf16x8*)(Vh + (size_t)((k0) + sr) * 1024); st_v1 = *(const bf16x8*)(Vh + (size_t)((k0) + 32 + sr) * 1024); } while (0)
#define WRITES_K(bf) do { *(bf16x8*)(lds + OFF_K + (bf) * SHM_K + kws) = st_k0; *(bf16x8*)(lds + OFF_K + (bf) * SHM_K + kws + 32 * 256) = st_k1;           \
                        if constexpr (MLA) *(bf16x8*)(lds + OFF_K2 + (bf) * SHM_K2 + k2ws) = st_k2; } while (0)
#define WRITES_V(bf) do { *(bf16x8*)(lds + OFF_V + (bf) * SHM_V + vst0) = st_v0; *(bf16x8*)(lds + OFF_V + (bf) * SHM_V + vst1) = st_v1; } while (0)
#define RESC(a) do { if (__any((a) < 1.f)) { if (hi == 0) al_l[r32] = (a); asm volatile("s_waitcnt lgkmcnt(0)" ::: "memory");              \
                     for (int d_ = 0; d_ < 4; ++d_) for (int r = 0; r < 16; ++r) o[d_][r] *= al_l[crow(r, hi)]; } } while (0)
#define ATT_STEP(t_, KB) do { const int t__ = (t_); const int k0__ = KEY0(t__); const bool more__ = t__ + 1 < NT;                                     \
        if (more__) { const int k1__ = KEY0(t__ + 1); LOADS_K(k1__); LOADS_V(k1__); } SBAR();                                                        \
        bool act__; int jb__ = 0; bool own__ = true;                                                                                                 \
        if constexpr (MLA) act__ = k0__ <= qlo + 31;                                                                                                 \
        else { jb__ = __builtin_amdgcn_readfirstlane(blist[t__ >> 2]); own__ = (jb__ == qb); act__ = own__ ? (k0__ <= qlo + 31) : (((wmask >> jb__) & 1ull) != 0ull); } \
        if (act__) { f32x16 p0, p1; float mn, al; bf16x8 pa0, pa1, pa2, pa3;                                                                        \
            qkt<KB, MLA>(p0, p1, lds, r32, hi, qr, q2p);                                                                                                  \
            if (own__) { if (k0__ + 63 > qlo) mask_tile(p0, p1, qm - k0__); }                                                                        \
            else { if (((rowmask >> jb__) & 1ull) == 0ull) { const float NEG = -__builtin_inff(); for (int r = 0; r < 16; ++r) { p0[r] = NEG; p1[r] = NEG; } } } \
            partialSM(p0, p1, m_reg, mn, al, C2); finishSM(p0, p1, al, l_reg, pa0, pa1, pa2, pa3); RESC(al);                                        \
            pv_tile<KB>(o, vb0, pa0, pa1, pa2, pa3); }                                                                                               \
        SBAR(); if (more__) { WRITES_K((KB) ^ 1); WRITES_V((KB) ^ 1); }                                                                              \
        __syncthreads(); } while (0)
    { const int k00 = KEY0(0); LOADS_K(k00); LOADS_V(k00); WRITES_K(0); WRITES_V(0); }
    __syncthreads();
    for (int t = 0; t < NT; t += 2) { ATT_STEP(t, 0); ATT_STEP(t + 1, 1); }
    if (hi == 0) li_l[r32] = l_reg;
    asm volatile("s_waitcnt lgkmcnt(0)" ::: "memory");
    bf16_t* Ow = io.O + (size_t)qlo * 1024 + h * 128;
#pragma unroll
    for (int r = 0; r < 16; ++r) { const int orow = crow(r, hi); const float rl = 1.0f / li_l[orow];
#pragma unroll
        for (int d0 = 0; d0 < 4; ++d0) { const float v = o[d0][r] * rl; const float vn = __shfl_xor(v, 1);
            if ((r32 & 1) == 0) *(unsigned*)(Ow + (size_t)orow * 1024 + d0 * 32 + r32) = cvtpk(v, vn); } }
    __syncthreads();
#undef KEY0
#undef LOADS_K
#undef LOADS_V
#undef WRITES_K
#undef WRITES_V
#undef RESC
#undef ATT_STEP
}
}

struct WJob { const float* s1; const float* s2; const float* gain; bf16_t* dst; int ld, K, map, ntn; };
__device__ __forceinline__ const float* wsrc(int map, const float* s1, const float* s2, int n) {
    if (map == 0) return s1 + n;
    if (map == 1) {
        if (n < 2048) { const int hb = n & ~127, c = n & 127; const int d = c < 32 ? ((c >> 1) + 16 * (c & 1)) : c; return s1 + hb + d; }
        if (n < 3840) return s1 + n;
        if (n < 3904) { const int c = n - 3840; return s1 + 3840 + (c >> 1) + 32 * (c & 1); }
        if (n < 4096) return nullptr;
        return s1 + 3904 + (n - 4096); }
    if (map == 2) {
        if (n < 1024) return s1 + (n >> 7) * 192 + (n & 127);
        const int c = n - 1024, h = c >> 6, cc = c & 63; return s1 + h * 192 + 128 + (cc >> 1) + 32 * (cc & 1); }
    { const int t = n >> 8, r = n & 255; return r < 128 ? s1 + 128 * t + r : s2 + 128 * t + (r - 128); }
}
__device__ __forceinline__ void wtile(const WJob& J, int tn, int tk, float* T) {
    const int tid = threadIdx.x, kk = tid >> 6, nn = tid & 63;
    const float* sp = wsrc(J.map, J.s1, J.s2, tn * 64 + nn);
#pragma unroll
    for (int i = 0; i < 8; ++i) { const int k = tk * 64 + i * 8 + kk; float v = sp ? sp[(size_t)k * J.ld] : 0.f; if (J.gain) v *= J.gain[k]; T[nn * 65 + i * 8 + kk] = v; }
    __syncthreads();
    { const int n2 = tid >> 3, k8 = (tid & 7) * 8; const float* tp = T + n2 * 65 + k8;
      u32x4 w; w.x = cvt_pk_bf16(tp[0], tp[1]); w.y = cvt_pk_bf16(tp[2], tp[3]); w.z = cvt_pk_bf16(tp[4], tp[5]); w.w = cvt_pk_bf16(tp[6], tp[7]);
      *(u32x4*)(J.dst + (size_t)(tn * 64 + n2) * J.K + tk * 64 + k8) = w; }
    __syncthreads();
}
__device__ __forceinline__ void sincos_rev(float ang, float& c, float& s) {
    const double rev = (double)ang * 0.15915494309189535; const float fr = (float)(rev - __builtin_rint(rev));
    c = __builtin_amdgcn_cosf(fr); s = __builtin_amdgcn_sinf(fr); }
__device__ __forceinline__ void phase0(const Params& P, char* lds) {
    const int tid = threadIdx.x, lane = tid & 63, wid = tid >> 6, gtid = blockIdx.x * 512 + tid, gsz = gridDim.x * 512;
    unsigned char* ws = P.ws;
    { float* z = (float*)(ws + WS_KMS); for (int i = gtid; i < 65536 + 65536 + 1024; i += gsz) z[i] = 0.f; }
    { float* csa = (float*)(ws + WS_CSA); float* csb = (float*)(ws + WS_CSB);
      for (int row = gtid; row < S_; row += gsz) { const float pf = (float)P.pos[row];
#pragma unroll
          for (int p = 0; p < 16; ++p) { float c, s; sincos_rev(pf * P.invf_a[p], c, s); csa[(size_t)row * 32 + 2 * p] = c; csa[(size_t)row * 32 + 2 * p + 1] = s; }
#pragma unroll
          for (int p = 0; p < 32; ++p) { float c, s; sincos_rev(pf * P.invf_b[p], c, s); csb[(size_t)row * 64 + 2 * p] = c; csb[(size_t)row * 64 + 2 * p + 1] = s; } } }
    { bf16_t* xn = (bf16_t*)(ws + WS_ACT + A_XN);
      for (int row = blockIdx.x * 8 + wid; row < S_; row += gridDim.x * 8) { const f32x4* xr = (const f32x4*)(P.x + (size_t)row * DM); f32x4 v[8]; float ss = 0.f;
#pragma unroll
          for (int i = 0; i < 8; ++i) { v[i] = xr[lane + 64 * i]; ss += sq4(v[i]); }
#pragma unroll
          for (int off = 32; off >= 1; off >>= 1) ss += __shfl_xor(ss, off);
          const float r = rstd_of(ss, 1.0f / 2048.0f);
#pragma unroll
          for (int i = 0; i < 8; ++i) { const f32x4 g = ((const f32x4*)P.attn_norm)[lane + 64 * i]; const f32x4 y = v[i] * r * g;
              uint2 w; w.x = cvt_pk_bf16(y[0], y[1]); w.y = cvt_pk_bf16(y[2], y[3]); ((uint2*)(xn + (size_t)row * DM))[lane + 64 * i] = w; } } }
    { float* T = (float*)lds;
      for (int t = blockIdx.x; t < 14912; t += gridDim.x) { WJob J; int lt;
          if (t < 4096) { lt = t; J = WJob{P.w_in, nullptr, nullptr, (bf16_t*)(ws + WS_WIN), 8000, 2048, 1, 128}; }
          else if (t < 4288) { lt = t - 4096; J = WJob{P.w_uq, nullptr, P.q_norm, (bf16_t*)(ws + WS_WUQ), 1536, 512, 2, 24}; }
          else if (t < 4416) { lt = t - 4288; J = WJob{P.w_ukv, nullptr, P.kv_norm, (bf16_t*)(ws + WS_WUKV), 2048, 256, 0, 32}; }
          else if (t < 4928) { lt = t - 4416; J = WJob{P.w_ba, nullptr, nullptr, (bf16_t*)(ws + WS_WBR), 2048, 1024, 0, 32}; }
          else if (t < 5440) { lt = t - 4928; J = WJob{P.w_bb, nullptr, nullptr, (bf16_t*)(ws + WS_WBR) + (size_t)2048 * 1024, 2048, 1024, 0, 32}; }
          else if (t < 6464) { lt = t - 5440; J = WJob{P.w_out, nullptr, nullptr, (bf16_t*)(ws + WS_WOUT), 2048, 2048, 0, 32}; }
          else if (t < 12096) { lt = t - 6464; J = WJob{P.w_gate, P.w_up, P.ffn_norm, (bf16_t*)(ws + WS_WGU), 5632, 2048, 3, 176}; }
          else { lt = t - 12096; J = WJob{P.w_down, nullptr, nullptr, (bf16_t*)(ws + WS_WDN), 2048, 5632, 0, 32}; }
          wtile(J, lt % J.ntn, lt / J.ntn, T); } }
}
__device__ __forceinline__ void moba_gate(const Params& P, char* lds) {
    const int tid = threadIdx.x; float* km = (float*)lds; unsigned char* ws = P.ws;
    const float* kms = (const float*)(ws + WS_KMS); const bf16_t* qa = (const bf16_t*)(ws + WS_ACT + A_QA); u64* sel = (u64*)(ws + WS_SEL);
    for (int item = blockIdx.x; item < 256; item += gridDim.x) { const int h = item & 7, chunk = item >> 3;
        __syncthreads();
        for (int i = tid; i < 8192; i += 512) km[i] = kms[h * 8192 + i] * (1.0f / 256.0f);
        __syncthreads();
        const int row = chunk * 512 + tid, blk = row >> 8, nblk = __builtin_amdgcn_readfirstlane(blk);
        const u32x4* qp = (const u32x4*)(qa + (size_t)row * 1024 + h * 128); u32x4 q[16];
#pragma unroll
        for (int i = 0; i < 16; ++i) q[i] = qp[i];
        float b1 = -__builtin_inff(), b2 = b1, b3 = b1; int i1 = 0, i2 = 0, i3 = 0;
        for (int n = 0; n < nblk; ++n) { const f32x4* kr = (const f32x4*)(km + n * 128); float a0 = 0.f, a1 = 0.f;
#pragma unroll
            for (int i = 0; i < 16; ++i) { const f32x4 ka = kr[2 * i], kb = kr[2 * i + 1]; const u32x4 qq = q[i];
                a0 += bflo(qq.x) * ka[0] + bfhi(qq.x) * ka[1] + bflo(qq.y) * ka[2] + bfhi(qq.y) * ka[3];
                a1 += bflo(qq.z) * kb[0] + bfhi(qq.z) * kb[1] + bflo(qq.w) * kb[2] + bfhi(qq.w) * kb[3]; }
            const float g = a0 + a1;
            if (g > b1) { b3 = b2; i3 = i2; b2 = b1; i2 = i1; b1 = g; i1 = n; }
            else if (g > b2) { b3 = b2; i3 = i2; b2 = g; i2 = n; }
            else if (g > b3) { b3 = g; i3 = n; } }
        u64 m = 0; if (blk >= 1) m |= 1ull << i1; if (blk >= 2) m |= 1ull << i2; if (blk >= 3) m |= 1ull << i3;
        sel[(size_t)row * 8 + h] = m; }
}

constexpr int LDS_BYTES = pg8::STAGE_BYTES;
__global__ void __launch_bounds__(512, 2) hybrid_fwd(Params P) {
    extern __shared__ __attribute__((aligned(16))) unsigned char lds_raw[];
    char* lds = (char*)lds_raw; PG8_LAS unsigned char* ldsg = (PG8_LAS unsigned char*)lds_raw;
    unsigned char* ws = P.ws; unsigned char* wa = ws + WS_ACT;
    const int tid = threadIdx.x, G = gridDim.x, c = blockIdx.x;
    const int lo = P.ph_lo, hi = P.ph_hi;
    float* ssq = (float*)(ws + WS_SSQ); float* ssq_q = ssq, * ssq_kv = ssq + S_, * ssq_h = ssq + 2 * S_, * ssq_o = ssq + 3 * S_;
    bf16_t* gates = (bf16_t*)P.out;
#ifndef PHMASK
#define PHMASK 0x1ff
#endif
#define IN(k) (((PHMASK >> (k)) & 1) && lo <= (k) && (k) < hi)
#define SEAM(k) do { if (IN(k) && IN((k) + 1)) cg::this_grid().sync(); } while (0)
    if (IN(0)) phase0(P, lds);
    SEAM(0);
    if (IN(1)) {
        pg8::Gemm g{(const bf16_t*)(wa + A_XN), (const bf16_t*)(ws + WS_WIN), S_, 8192, 2048}; pg8::StaticOrder so; so.init(S_, 8192, G, c);
        EpiProj E{(bf16_t*)(wa + A_QA), (bf16_t*)(wa + A_KA), (bf16_t*)(wa + A_VA), (bf16_t*)(wa + A_CQ), (bf16_t*)(wa + A_CKV), (bf16_t*)(wa + A_KRP), gates,
                  (const float*)(ws + WS_CSA), (const float*)(ws + WS_CSB), (float*)(ws + WS_KMS), ssq_q, ssq_kv};
        pg8::gemm_phase<EpiProj, pg8::StaticOrder, false>(ldsg, g, so, E, nullptr);
    }
    SEAM(1);
    if (IN(2)) {
#ifndef NO_G2A
        { pg8::Gemm g{(const bf16_t*)(wa + A_CQ), (const bf16_t*)(ws + WS_WUQ), S_, 1536, 512}; pg8::StaticOrder so; so.init(S_, 1536, G, c);
          EpiQ E{(bf16_t*)(wa + A_QN), (bf16_t*)(wa + A_QRP), (const float*)(ws + WS_CSB), ssq_q};
          pg8::gemm_phase<EpiQ, pg8::StaticOrder, false>(ldsg, g, so, E, nullptr); }
#endif
#ifndef NO_G2B
        { int kk = 256; asm volatile("" : "+s"(kk));
          pg8::Gemm g{(const bf16_t*)(wa + A_CKV), (const bf16_t*)(ws + WS_WUKV), S_, 2048, kk}; pg8::StaticOrder so; so.init(S_, 2048, G, c);
          EpiKV E{(bf16_t*)(wa + A_KN), (bf16_t*)(wa + A_VB), ssq_kv};
          pg8::gemm_phase<EpiKV, pg8::StaticOrder, false>(ldsg, g, so, E, nullptr); }
#endif
#ifndef NO_GATE
        moba_gate(P, lds);
#endif
    }
    SEAM(2);
    if (IN(3)) {
        unsigned* ctr = (unsigned*)(ws + WS_CTL); int* itp = (int*)(lds + att::OFF_MISC + 64 + 67 * 4);
        att::AttnIO mla{(const bf16_t*)(wa + A_QN), (const bf16_t*)(wa + A_QRP), (const bf16_t*)(wa + A_KN), (const bf16_t*)(wa + A_KRP), (const bf16_t*)(wa + A_VB), (bf16_t*)(wa + A_Y) + (size_t)S_ * 1024, nullptr};
        att::AttnIO mob{(const bf16_t*)(wa + A_QA), nullptr, (const bf16_t*)(wa + A_KA), nullptr, (const bf16_t*)(wa + A_VA), (bf16_t*)(wa + A_Y), (const u64*)(ws + WS_SEL)};
#ifndef NO_MLA
        for (;;) {
            if (tid == 0) *itp = (int)atomicAdd(ctr, 1u);
            __syncthreads();
            const int it = __builtin_amdgcn_readfirstlane(*itp);
            __syncthreads();
            if (it >= 512) break;
            att::attn_item<true>(lds, mla, it & 7, 63 - (it >> 3), 1.4426950408889634f * 0.07216878364870323f);
        }
#endif
#ifndef NO_MOBA
        for (;;) {
            if (tid == 0) *itp = (int)atomicAdd(ctr + 1, 1u);
            __syncthreads();
            const int it = __builtin_amdgcn_readfirstlane(*itp);
            __syncthreads();
            if (it >= 512) break;
            att::attn_item<false>(lds, mob, it & 7, 63 - (it >> 3), 1.4426950408889634f * 0.08838834764831845f);
        }
#endif
    }
    SEAM(3);
    if (IN(4)) {
        pg8::Gemm g{(const bf16_t*)(wa + A_Y), (const bf16_t*)(ws + WS_WBR), 2 * S_, 4096, 1024}; BranchOrder bo; bo.init(G, c);
        EpiBranch E{gates, (float*)(wa + A_T), (bf16_t*)(wa + A_MIX)};
        pg8::gemm_phase<EpiBranch, BranchOrder, false>(ldsg, g, bo, E, nullptr);
    }
    SEAM(4);
    if (IN(5)) {
        pg8::Gemm g{(const bf16_t*)(wa + A_MIX), (const bf16_t*)(ws + WS_WOUT), S_, 2048, 2048}; pg8::StaticOrder so; so.init(S_, 2048, G, c);
        EpiOut E{P.x, (float*)(wa + A_HF), (bf16_t*)(wa + A_HB), ssq_h};
        pg8::gemm_phase<EpiOut, pg8::StaticOrder, false>(ldsg, g, so, E, nullptr);
    }
    SEAM(5);
    if (IN(6)) {
        pg8::Gemm g{(const bf16_t*)(wa + A_HB), (const bf16_t*)(ws + WS_WGU), S_, 11264, 2048}; pg8::StaticOrder so; so.init(S_, 11264, G, c);
        EpiGU E{(bf16_t*)(wa + A_ACTV), ssq_h};
        pg8::gemm_phase<EpiGU, pg8::StaticOrder, false>(ldsg, g, so, E, nullptr);
    }
    SEAM(6);
    if (IN(7)) {
        pg8::Gemm g{(const bf16_t*)(wa + A_ACTV), (const bf16_t*)(ws + WS_WDN), S_, 2048, DFF}; pg8::StaticOrder so; so.init(S_, 2048, G, c);
        EpiDown E{(const float*)(wa + A_HF), P.out, ssq_o};
        pg8::gemm_phase<EpiDown, pg8::StaticOrder, false>(ldsg, g, so, E, nullptr);
    }
    SEAM(7);
    if (IN(8)) {
        const int lane = tid & 63, wid = tid >> 6;
        for (int row = c * 8 + wid; row < S_; row += G * 8) { const float r = rstd_of(ssq_o[row], 1.0f / 2048.0f); f32x4* op = (f32x4*)(P.out + (size_t)row * DM);
#pragma unroll
            for (int i = 0; i < 8; ++i) { const f32x4 g = ((const f32x4*)P.final_norm)[lane + 64 * i]; op[lane + 64 * i] = op[lane + 64 * i] * r * g; } }
    }
#ifdef PROBE_CHECK
    if (lo <= 9 && 9 < hi) check_phase(P, lds);
    if (lo <= 10 && 10 < hi) { if (c == 0 && tid == 0) { const unsigned c0 = ((const unsigned*)(ws + WS_CTL))[8 + 41], c4 = ((const unsigned*)(ws + WS_CTL))[8 + 42]; P.out[0] += 10.0f * (float)(10 + c0 + 17 * (c4 > 4 ? 4 : c4)); } }
#endif
#undef IN
#undef SEAM
}

#ifndef MK_FUSED
#define MK_FUSED 0
#endif
extern "C" void kernel_launch(void* const* d_in, const int* in_sizes, int n_in, void* d_out, int out_size, void* d_ws, size_t ws_size, hipStream_t stream) {
    static int grid = 0;
    if (grid == 0) {
        int dev = 0, cus = 0, per_cu = 0;
        (void)hipGetDevice(&dev); (void)hipDeviceGetAttribute(&cus, hipDeviceAttributeMultiprocessorCount, dev);
        if (hipFuncSetAttribute((const void*)hybrid_fwd, hipFuncAttributeMaxDynamicSharedMemorySize, LDS_BYTES) != hipSuccess) fprintf(stderr, "hipFuncSetAttribute failed\n");
        if (hipOccupancyMaxActiveBlocksPerMultiprocessor(&per_cu, (const void*)hybrid_fwd, 512, LDS_BYTES) != hipSuccess || per_cu < 1) { fprintf(stderr, "occupancy query: %d\n", per_cu); per_cu = 1; }
        (void)hipGetLastError();
        if (cus <= 0) cus = 256;
        grid = cus * (per_cu > 1 ? 1 : per_cu);
        if (ws_size < WS_END) fprintf(stderr, "kernel_launch: workspace %zu < %zu\n", ws_size, (size_t)WS_END);
    }
    Params p{};
    p.x = (const float*)d_in[0]; p.pos = (const int*)d_in[1]; p.attn_norm = (const float*)d_in[2]; p.w_in = (const float*)d_in[3]; p.q_norm = (const float*)d_in[4];
    p.w_uq = (const float*)d_in[5]; p.kv_norm = (const float*)d_in[6]; p.w_ukv = (const float*)d_in[7]; p.w_ba = (const float*)d_in[8]; p.w_bb = (const float*)d_in[9];
    p.w_out = (const float*)d_in[10]; p.ffn_norm = (const float*)d_in[11]; p.w_gate = (const float*)d_in[12]; p.w_up = (const float*)d_in[13]; p.w_down = (const float*)d_in[14];
    p.final_norm = (const float*)d_in[15]; p.out = (float*)d_out; p.ws = (unsigned char*)d_ws;
    for (int i = 0; i < 16; ++i) p.invf_a[i] = (float)std::pow(500000.0, -(double)(2 * i) / 32.0);
    for (int i = 0; i < 32; ++i) p.invf_b[i] = (float)std::pow(500000.0, -(double)(2 * i) / 64.0);
#if MK_FUSED
    p.ph_lo = 0; p.ph_hi = 9;
    void* args[] = {&p};
    hipError_t e = hipLaunchCooperativeKernel((const void*)hybrid_fwd, dim3(grid), dim3(512), args, LDS_BYTES, stream);
    if (e != hipSuccess) fprintf(stderr, "cooperative launch failed: %s (grid %d)\n", hipGetErrorString(e), grid);
#else
#ifdef PROBE_CHECK
    { const int seq[11] = {0, 1, 9, 2, 3, 4, 5, 6, 7, 8, 10};
      for (int i = 0; i < 11; ++i) { p.ph_lo = seq[i]; p.ph_hi = seq[i] + 1; hipLaunchKernelGGL(hybrid_fwd, dim3(grid), dim3(512), LDS_BYTES, stream, p); } }
#else
    for (int ph = 0; ph < 9; ++ph) { p.ph_lo = ph; p.ph_hi = ph + 1; hipLaunchKernelGGL(hybrid_fwd, dim3(grid), dim3(512), LDS_BYTES, stream, p); }
#endif
#endif
}
```

```cpp
#define MK_FUSED 1
#include <hip/hip_runtime.h>
#include <hip/hip_cooperative_groups.h>
#include <cstdio>
#include <cstdint>
#include <cmath>
namespace cg = cooperative_groups;
namespace pg8 {
#define PG8_LAS __attribute__((address_space(3)))
typedef unsigned short bf16_t;
typedef short bf16x8 __attribute__((ext_vector_type(8)));
typedef float f32x4 __attribute__((ext_vector_type(4)));
typedef unsigned u32x4 __attribute__((ext_vector_type(4)));
constexpr int BM = 256, BK = 64, HALF = 128, HTB = HALF * BK * 2  , STAGE_BYTES = 8 * HTB, NXCD = 8, WGM = 8;

__host__ __device__ __forceinline__ int lds_byte(int r, int c) { const int st = (r >> 4) * 2 + (c >> 5), rr = r & 15, cc = c & 31, ob = rr * 64 + cc * 2; return st * 1024 + (ob ^ (((ob >> 9) & 1) << 5)); }
__host__ __device__ __forceinline__ void stage_rc(int b, int& R, int& C) { const int st = b / 1024, sb = b % 1024, swz = sb ^ (((sb >> 9) & 1) << 5); R = (st >> 1) * 16 + swz / 64; C = (st & 1) * 32 + (swz % 64) / 2; }
__host__ __device__ __forceinline__ int perm32(int rho) { const int n = rho >> 4, i = rho & 15; return 8 * (i >> 2) + 4 * n + (i & 3); }

struct Unit { int pm, pn; };
struct Gemm { const bf16_t* A; const bf16_t* Bt; int M, N, K; };

struct StaticOrder {
    int nM, nN, nwg, G, c;
    __host__ __device__ void init(int M, int N, int G_, int c_) { nM = M / BM; nN = N / BM; nwg = nM * nN; G = G_; c = c_; }
    __host__ __device__ bool next(int i, Unit& u) const {
        const long L = (long)i * G + c; if (L >= nwg) return false;
        int wgid = (int)L; { const int q = nwg / NXCD, r = nwg % NXCD, xcd = wgid % NXCD, off = wgid / NXCD; wgid = (xcd < r ? xcd * (q + 1) : r * (q + 1) + (xcd - r) * q) + off; }
        const int nig = WGM * nN, gid = wgid / nig, fm = gid * WGM, gsz = (nM - fm) < WGM ? (nM - fm) : WGM;
        u.pm = fm + ((wgid % nig) % gsz); u.pn = (wgid % nig) / gsz; return true;
    }
    __device__ __forceinline__ void a_ready(const Unit&) const {}
    __device__ __forceinline__ void done(const Unit&) const {}
};
typedef __bf16 bf16x2_n __attribute__((ext_vector_type(2)));
__device__ __forceinline__ unsigned cvt_pk_bf16(float lo, float hi) { bf16x2_n v = {(__bf16)lo, (__bf16)hi}; return __builtin_bit_cast(unsigned, v); }
typedef float f32x2 __attribute__((ext_vector_type(2)));
template <class Epi, class Sched, bool STAMP = false>
__device__ __forceinline__ void gemm_phase(PG8_LAS unsigned char* lds, const Gemm g, const Sched& S, const Epi& E, unsigned long long* stamps) {
    const int tid = threadIdx.x, wid = __builtin_amdgcn_readfirstlane(tid >> 6), lane = tid & 63, wr = wid >> 2, wc = wid & 3, fr = lane & 15, fq = lane >> 4;
    const int K = g.K, nt = K / BK;
    int ts_lo = 0, ts_hi = 0, nts = 0; const unsigned long long rt_entry = STAMP ? (unsigned long long)wall_clock64() : 0ull;
#define PG8_STAMP() do { if (STAMP && wid == 0 && nts < 64) { const unsigned long long _c = (unsigned long long)clock64(); \
        ts_lo = (lane == nts) ? (int)(unsigned)_c : ts_lo; ts_hi = (lane == nts) ? (int)(unsigned)(_c >> 32) : ts_hi; ++nts; } } while (0)
    PG8_STAMP();
    unsigned voffA[2], voffB[2];
#pragma unroll
    for (int i = 0; i < 2; ++i) { int R, C; stage_rc(tid * 16 + i * 8192, R, C); const int Rb = Epi::PERM ? ((R & ~31) + perm32(R & 31)) : R;
        voffA[i] = (unsigned)(R * K + C) * 2u; voffB[i] = (unsigned)(Rb * K + C) * 2u; }
    const size_t kstep = (size_t)(BK * 2);
    const size_t hstep = (size_t)HALF * K * 2;
    const size_t tstep = 2 * hstep;
    const unsigned ldsw = (unsigned)wid * 1024u;
    const int aoff = lds_byte(wr * 64 + fr, fq * 8), boff = lds_byte(wc * 32 + fr, fq * 8);
#define PG8_SA(b, h) (((b) * 2 + (h)) * HTB)
#define PG8_SB(b, h) ((4 + (b) * 2 + (h)) * HTB)
#define PG8_STAGE(bufoff, gbase, voff) do { _Pragma("unroll") for (int _i = 0; _i < 2; ++_i) \
        __builtin_amdgcn_global_load_lds((const unsigned*)((const char*)(gbase) + (voff)[_i]), (PG8_LAS unsigned*)(lds + (bufoff) + ldsw + _i * 8192), 16, 0, 0); } while (0)
#define PG8_LDA(dst, b, h) do { _Pragma("unroll") for (int m = 0; m < 4; ++m) _Pragma("unroll") for (int k = 0; k < 2; ++k) dst[m][k] = *(const PG8_LAS bf16x8*)(lds + PG8_SA(b, h) + aoff + m * 2048 + k * 1024); } while (0)
#define PG8_LDB(dst, b, h) do { _Pragma("unroll") for (int n = 0; n < 2; ++n) _Pragma("unroll") for (int k = 0; k < 2; ++k) dst[n][k] = *(const PG8_LAS bf16x8*)(lds + PG8_SB(b, h) + boff + n * 2048 + k * 1024); } while (0)
#define PG8_MMA(ai, bj, At, Bt) do { __builtin_amdgcn_s_setprio(1); _Pragma("unroll") for (int m = 0; m < 4; ++m) _Pragma("unroll") for (int n = 0; n < 2; ++n) _Pragma("unroll") for (int k = 0; k < 2; ++k) \
        acc[ai][bj][m][n] = __builtin_amdgcn_mfma_f32_16x16x32_bf16(Bt[n][k], At[m][k], acc[ai][bj][m][n], 0, 0, 0); __builtin_amdgcn_s_setprio(0); } while (0)
#define PG8_WAIT_V(n) asm volatile("s_waitcnt vmcnt(" #n ")" ::: "memory")
#define PG8_WAIT_L(n) asm volatile("s_waitcnt lgkmcnt(" #n ")" ::: "memory")
#define PG8_BAR __builtin_amdgcn_s_barrier()
#define PG8_SCHED __builtin_amdgcn_sched_barrier(0)
    Unit cur, nxt; int ui = 0;
    if (!S.next(0, cur)) return;
    f32x4 acc[2][2][4][2];
#pragma unroll
    for (int a = 0; a < 2; ++a)
#pragma unroll
        for (int b = 0; b < 2; ++b)
#pragma unroll
            for (int m = 0; m < 4; ++m)
#pragma unroll
                for (int n = 0; n < 2; ++n) acc[a][b][m][n] = (f32x4){0.f, 0.f, 0.f, 0.f};
    bf16x8 At[4][2], B0[2][2], B1[2][2];
    const char* cA = (const char*)g.A + (size_t)cur.pm * tstep; const char* cB = (const char*)g.Bt + (size_t)cur.pn * tstep;
    S.a_ready(cur);
    PG8_STAGE(PG8_SB(0, 0), cB, voffB); PG8_STAGE(PG8_SA(0, 0), cA, voffA); PG8_STAGE(PG8_SB(0, 1), cB + hstep, voffB); PG8_STAGE(PG8_SA(0, 1), cA + hstep, voffA);
    if (wr == 1) PG8_BAR;
    PG8_WAIT_V(4); PG8_BAR;
    PG8_STAGE(PG8_SB(1, 0), cB + kstep, voffB); PG8_STAGE(PG8_SA(1, 0), cA + kstep, voffA); PG8_STAGE(PG8_SB(1, 1), cB + hstep + kstep, voffB);
    PG8_WAIT_V(6); PG8_BAR;
    PG8_STAMP();
    for (;;) {
        const bool has_next = S.next(ui + 1, nxt);
        const char* nA = has_next ? (const char*)g.A + (size_t)nxt.pm * tstep : cA; const char* nB = has_next ? (const char*)g.Bt + (size_t)nxt.pn * tstep : cB;
        for (int t = 0; t < nt; t += 2) {
            const bool last = (t == nt - 2);
            const char* a1 = cA + (size_t)(t + 1) * kstep;
            const char* a2 = last ? nA : cA + (size_t)(t + 2) * kstep; const char* b2 = last ? nB : cB + (size_t)(t + 2) * kstep;
            const char* a3 = a2 + kstep; const char* b3 = b2 + kstep;
            if (last && has_next) S.a_ready(nxt);
            PG8_LDB(B0, 0, 0); PG8_SCHED; PG8_LDA(At, 0, 0); PG8_STAGE(PG8_SA(1, 1), a1 + hstep, voffA);
            PG8_WAIT_L(8); PG8_BAR; PG8_WAIT_L(0); PG8_MMA(0, 0, At, B0); PG8_BAR; PG8_SCHED;
            PG8_LDB(B1, 0, 1); PG8_STAGE(PG8_SB(0, 0), b2, voffB);
            PG8_BAR; PG8_WAIT_L(0); PG8_MMA(0, 1, At, B1); PG8_BAR;
            PG8_LDA(At, 0, 1); PG8_STAGE(PG8_SA(0, 0), a2, voffA);
            PG8_BAR; PG8_WAIT_L(0); PG8_MMA(1, 0, At, B0); PG8_BAR; PG8_SCHED;
            PG8_STAGE(PG8_SB(0, 1), b2 + hstep, voffB);
            PG8_WAIT_V(6); PG8_BAR; PG8_MMA(1, 1, At, B1); PG8_BAR;
            PG8_LDB(B0, 1, 0); PG8_SCHED; PG8_LDA(At, 1, 0); PG8_STAGE(PG8_SA(0, 1), a2 + hstep, voffA);
            PG8_WAIT_L(8); PG8_BAR; PG8_WAIT_L(0); PG8_MMA(0, 0, At, B0); PG8_BAR; PG8_SCHED;
            PG8_LDB(B1, 1, 1); PG8_STAGE(PG8_SB(1, 0), b3, voffB);
            PG8_BAR; PG8_WAIT_L(0); PG8_MMA(0, 1, At, B1); PG8_BAR;
            PG8_LDA(At, 1, 1); PG8_STAGE(PG8_SA(1, 0), a3, voffA);
            PG8_BAR; PG8_WAIT_L(0); PG8_MMA(1, 0, At, B0); PG8_BAR; PG8_SCHED;
            PG8_STAGE(PG8_SB(1, 1), b3 + hstep, voffB);
            PG8_WAIT_V(6); PG8_BAR; PG8_MMA(1, 1, At, B1); PG8_BAR;
        }
        PG8_STAMP();
        if constexpr (!Epi::AFTER_DRAIN) { E(acc, cur, wr, wc, fr, fq); S.done(cur); }
        PG8_STAMP();
        if (!has_next) break;
#pragma unroll
        for (int a = 0; a < 2; ++a)
#pragma unroll
            for (int b = 0; b < 2; ++b)
#pragma unroll
                for (int m = 0; m < 4; ++m)
#pragma unroll
                    for (int n = 0; n < 2; ++n) acc[a][b][m][n] = (f32x4){0.f, 0.f, 0.f, 0.f};
        cur = nxt; cA = nA; cB = nB; ++ui;
    }
    PG8_WAIT_V(0);
    if (wr == 0) PG8_BAR;
    PG8_BAR;
    if constexpr (Epi::AFTER_DRAIN) { E.fused(acc, cur, wr, wc, fr, fq, lds, wid, lane); S.done(cur); }
    PG8_STAMP();
    if (STAMP && wid == 0) { stamps[lane] = lane < nts ? (((unsigned long long)(unsigned)ts_hi << 32) | (unsigned)ts_lo) : 0ull;
        if (lane == 62) stamps[62] = rt_entry; if (lane == 63) stamps[63] = (unsigned long long)wall_clock64(); }
#undef PG8_STAMP
#undef PG8_SA
#undef PG8_SB
#undef PG8_STAGE
#undef PG8_LDA
#undef PG8_LDB
#undef PG8_MMA
#undef PG8_WAIT_V
#undef PG8_WAIT_L
#undef PG8_BAR
#undef PG8_SCHED
}
}

using pg8::bf16_t; using pg8::bf16x8; using pg8::f32x4; using pg8::u32x4; using pg8::Unit; using pg8::cvt_pk_bf16;
typedef short s16x4 __attribute__((ext_vector_type(4)));
typedef float f32x16 __attribute__((ext_vector_type(16)));
typedef unsigned long long u64;
constexpr int S_ = 16384, DM = 2048, DFF = 5632;
constexpr float EPS_ = 1e-6f;
constexpr size_t MiB = (size_t)1 << 20;
constexpr size_t WS_WIN = 0, WS_WUQ = 32 * MiB, WS_WUKV = WS_WUQ + 3 * MiB / 2, WS_WBR = WS_WUKV + MiB, WS_WOUT = WS_WBR + 8 * MiB, WS_WGU = WS_WOUT + 8 * MiB,
                 WS_WDN = WS_WGU + 44 * MiB, WS_CSA = WS_WDN + 22 * MiB, WS_CSB = WS_CSA + 2 * MiB, WS_SEL = WS_CSB + 4 * MiB, WS_KMS = WS_SEL + MiB,
                 WS_SSQ = WS_KMS + MiB / 4, WS_CTL = WS_SSQ + MiB / 4, WS_BAR = WS_CTL + 65536, WS_ACT = 128 * MiB, WS_END = 512 * MiB;
static_assert(WS_BAR + 4096 <= WS_ACT, "ws map");
constexpr size_t A_XN = 0, A_QA = 64 * MiB, A_KA = 96 * MiB, A_VA = 128 * MiB, A_CQ = 160 * MiB, A_CKV = 176 * MiB, A_KRP = 184 * MiB,
                 A_QN = 0, A_KN = 32 * MiB, A_VB = 192 * MiB, A_QRP = 224 * MiB, A_Y = 240 * MiB, A_T = 0, A_MIX = 128 * MiB,
                 A_HF = 256 * MiB, A_HB = 0, A_ACTV = 64 * MiB,
                 A_P0 = 304 * MiB, A_P1 = 336 * MiB, A_ML = 368 * MiB, A_LIST = 372 * MiB;

struct Params {
    const float* x; const int* pos; const float* attn_norm; const float* w_in; const float* q_norm; const float* w_uq; const float* kv_norm; const float* w_ukv;
    const float* w_ba; const float* w_bb; const float* w_out; const float* ffn_norm; const float* w_gate; const float* w_up; const float* w_down; const float* final_norm;
    float* out; unsigned char* ws;
    float invf_a[16]; float invf_b[32];
    int ph_lo, ph_hi;
};

__device__ __forceinline__ float bflo(unsigned u) { return __uint_as_float(u << 16); }
__device__ __forceinline__ float bfhi(unsigned u) { return __uint_as_float(u & 0xffff0000u); }
__device__ __forceinline__ void st8(bf16_t* p, f32x4 a, f32x4 b) {
    u32x4 w; w.x = cvt_pk_bf16(a[0], a[1]); w.y = cvt_pk_bf16(a[2], a[3]); w.z = cvt_pk_bf16(b[0], b[1]); w.w = cvt_pk_bf16(b[2], b[3]); *(u32x4*)p = w; }
__device__ __forceinline__ void rot4(f32x4& v, const f32x4 t) {
    const float a0 = v[0] * t[0] - v[1] * t[1], a1 = v[1] * t[0] + v[0] * t[1], b0 = v[2] * t[2] - v[3] * t[3], b1 = v[3] * t[2] + v[2] * t[3];
    v[0] = a0; v[1] = a1; v[2] = b0; v[3] = b1; }
__device__ __forceinline__ float sigm(float x) { return __builtin_amdgcn_rcpf(1.0f + __builtin_amdgcn_exp2f(x * -1.4426950408889634f)); }
__device__ __forceinline__ float sq4(const f32x4 v) { return (v[0] * v[0] + v[1] * v[1]) + (v[2] * v[2] + v[3] * v[3]); }
__device__ __forceinline__ float rstd_of(float ssq, float inv_n) { return __builtin_amdgcn_rsqf(ssq * inv_n + EPS_); }

struct EpiProj {
    static constexpr bool PERM = true, AFTER_DRAIN = false;
    bf16_t *qa, *ka, *va, *cq, *ckv, *krp, *gates; const float* csa; const float* csb; float *kms, *ssq_q, *ssq_kv;
    __device__ __forceinline__ void operator()(const f32x4 (&acc)[2][2][4][2], const Unit& u, int wr, int wc, int fr, int fq) const {
        const int pn = u.pn, row0 = u.pm * 256 + wr * 64 + fr, cl = wc * 32 + 8 * fq;
        if (pn < 8) {
            bf16_t* dst = pn < 4 ? qa : ka; const bool isk = pn >= 4; const int hb = (pn & 3) * 256;
            float ks[2][8];
#pragma unroll
            for (int b = 0; b < 2; ++b)
#pragma unroll
                for (int i = 0; i < 8; ++i) ks[b][i] = 0.f;
#pragma unroll
            for (int ai = 0; ai < 2; ++ai)
#pragma unroll
            for (int mh = 0; mh < 2; ++mh) {
                f32x4 tt0[4], tt1[4];
#pragma unroll
                for (int m = 2 * mh; m < 2 * mh + 2; ++m) { tt0[m] = (f32x4){1.f, 0.f, 1.f, 0.f}; tt1[m] = tt0[m];
                    if (wc == 0) { const f32x4* tp = (const f32x4*)(csa + (size_t)(row0 + ai * 128 + m * 16) * 32 + 8 * fq); tt0[m] = tp[0]; tt1[m] = tp[1]; } }
#pragma unroll
                for (int m = 2 * mh; m < 2 * mh + 2; ++m) { const int row = row0 + ai * 128 + m * 16; const f32x4 t0 = tt0[m], t1 = tt1[m];
#pragma unroll
                    for (int bj = 0; bj < 2; ++bj) { f32x4 v0 = acc[ai][bj][m][0], v1 = acc[ai][bj][m][1];
                        if (wc == 0) { rot4(v0, t0); rot4(v1, t1); }
                        if (isk) {
#pragma unroll
                            for (int i = 0; i < 4; ++i) { ks[bj][i] += v0[i]; ks[bj][4 + i] += v1[i]; } }
                        st8(dst + (size_t)row * 1024 + hb + bj * 128 + cl, v0, v1); } } }
            if (isk) {
#pragma unroll
                for (int bj = 0; bj < 2; ++bj)
#pragma unroll
                    for (int i = 0; i < 8; ++i) { float s = ks[bj][i]; s += __shfl_xor(s, 1); s += __shfl_xor(s, 2); s += __shfl_xor(s, 4); s += __shfl_xor(s, 8);
                        if (fr == 0) atomicAdd(kms + ((size_t)((pn & 3) * 2 + bj) * 64 + u.pm) * 128 + cl + i, s); } }
        } else if (pn < 12) {
#pragma unroll
            for (int ai = 0; ai < 2; ++ai)
#pragma unroll
                for (int m = 0; m < 4; ++m) { const int row = row0 + ai * 128 + m * 16;
#pragma unroll
                    for (int bj = 0; bj < 2; ++bj) st8(va + (size_t)row * 1024 + (pn - 8) * 256 + bj * 128 + cl, acc[ai][bj][m][0], acc[ai][bj][m][1]); }
        } else if (pn < 15) {
            const bool isq = pn < 14; bf16_t* dst = isq ? cq : ckv; const int ld = isq ? 512 : 256, cb = isq ? (pn - 12) * 256 : 0; float* ssq = isq ? ssq_q : ssq_kv;
#pragma unroll
            for (int ai = 0; ai < 2; ++ai)
#pragma unroll
                for (int m = 0; m < 4; ++m) { const int row = row0 + ai * 128 + m * 16; float s = 0.f;
#pragma unroll
                    for (int bj = 0; bj < 2; ++bj) { s += sq4(acc[ai][bj][m][0]) + sq4(acc[ai][bj][m][1]); st8(dst + (size_t)row * ld + cb + bj * 128 + cl, acc[ai][bj][m][0], acc[ai][bj][m][1]); }
                    s += __shfl_xor(s, 16); s += __shfl_xor(s, 32);
                    if (fq == 0) atomicAdd(ssq + row, s); }
        } else if (pn == 15) {
            if (wc < 2) {
#pragma unroll
                for (int ai = 0; ai < 2; ++ai)
#pragma unroll
                for (int mh = 0; mh < 2; ++mh) { f32x4 tt0[4], tt1[4];
#pragma unroll
                    for (int m = 2 * mh; m < 2 * mh + 2; ++m) { const f32x4* tp = (const f32x4*)(csb + (size_t)(row0 + ai * 128 + m * 16) * 64 + 32 * wc + 8 * fq); tt0[m] = tp[0]; tt1[m] = tp[1]; }
#pragma unroll
                    for (int m = 2 * mh; m < 2 * mh + 2; ++m) { const int row = row0 + ai * 128 + m * 16; f32x4 v0 = acc[ai][0][m][0], v1 = acc[ai][0][m][1];
                        rot4(v0, tt0[m]); rot4(v1, tt1[m]); st8(krp + (size_t)row * 64 + cl, v0, v1); } } }
        } else {
#pragma unroll
            for (int ai = 0; ai < 2; ++ai)
#pragma unroll
                for (int m = 0; m < 4; ++m) { const int row = row0 + ai * 128 + m * 16;
#pragma unroll
                    for (int bj = 0; bj < 2; ++bj) { f32x4 v0 = acc[ai][bj][m][0], v1 = acc[ai][bj][m][1];
#pragma unroll
                        for (int i = 0; i < 4; ++i) { v0[i] = sigm(v0[i]); v1[i] = sigm(v1[i]); }
                        st8(gates + (size_t)row * 4096 + (pn - 16) * 256 + bj * 128 + cl, v0, v1); } }
        }
    }
};
struct EpiQ {
    static constexpr bool PERM = true, AFTER_DRAIN = false;
    bf16_t *qn, *qrp; const float* csb; const float* ssq_q;
    __device__ __forceinline__ void operator()(const f32x4 (&acc)[2][2][4][2], const Unit& u, int wr, int wc, int fr, int fq) const {
        const int pn = u.pn, row0 = u.pm * 256 + wr * 64 + fr, cl = wc * 32 + 8 * fq;
        float sq[2][4];
#pragma unroll
        for (int ai = 0; ai < 2; ++ai)
#pragma unroll
            for (int m = 0; m < 4; ++m) sq[ai][m] = ssq_q[row0 + ai * 128 + m * 16];
#pragma unroll
        for (int ai = 0; ai < 2; ++ai)
#pragma unroll
        for (int mh = 0; mh < 2; ++mh) { f32x4 tt0[4], tt1[4];
#pragma unroll
            for (int m = 2 * mh; m < 2 * mh + 2; ++m) if (pn >= 4) { const f32x4* tp = (const f32x4*)(csb + (size_t)(row0 + ai * 128 + m * 16) * 64 + 32 * (wc & 1) + 8 * fq); tt0[m] = tp[0]; tt1[m] = tp[1]; }
#pragma unroll
            for (int m = 2 * mh; m < 2 * mh + 2; ++m) { const int row = row0 + ai * 128 + m * 16; const float r = rstd_of(sq[ai][m], 1.0f / 512.0f);
                if (pn < 4) {
#pragma unroll
                    for (int bj = 0; bj < 2; ++bj) st8(qn + (size_t)row * 1024 + pn * 256 + bj * 128 + cl, acc[ai][bj][m][0] * r, acc[ai][bj][m][1] * r);
                } else { const f32x4 t0 = tt0[m], t1 = tt1[m];
#pragma unroll
                    for (int bj = 0; bj < 2; ++bj) { f32x4 v0 = acc[ai][bj][m][0] * r, v1 = acc[ai][bj][m][1] * r; rot4(v0, t0); rot4(v1, t1);
                        st8(qrp + (size_t)row * 512 + (pn - 4) * 256 + bj * 128 + cl, v0, v1); } } } }
    }
};
struct EpiKV {
    static constexpr bool PERM = true, AFTER_DRAIN = false;
    bf16_t *kn, *vb; const float* ssq_kv;
    __device__ __forceinline__ void operator()(const f32x4 (&acc)[2][2][4][2], const Unit& u, int wr, int wc, int fr, int fq) const {
        const int pn = u.pn, row0 = u.pm * 256 + wr * 64 + fr, cl = wc * 32 + 8 * fq;
        float sq[2][4];
#pragma unroll
        for (int ai = 0; ai < 2; ++ai)
#pragma unroll
            for (int m = 0; m < 4; ++m) sq[ai][m] = ssq_kv[row0 + ai * 128 + m * 16];
#pragma unroll
        for (int ai = 0; ai < 2; ++ai)
#pragma unroll
            for (int m = 0; m < 4; ++m) { const int row = row0 + ai * 128 + m * 16; const float r = rstd_of(sq[ai][m], 1.0f / 256.0f);
                st8(kn + (size_t)row * 1024 + pn * 128 + cl, acc[ai][0][m][0] * r, acc[ai][0][m][1] * r);
                st8(vb + (size_t)row * 1024 + pn * 128 + cl, acc[ai][1][m][0] * r, acc[ai][1][m][1] * r);
                asm volatile("" ::: "memory"); }
    }
};
struct EpiBranch {
    static constexpr bool PERM = true, AFTER_DRAIN = false;
    const bf16_t* gates; bf16_t* T; bf16_t* mixed;
    __device__ __forceinline__ void operator()(const f32x4 (&acc)[2][2][4][2], const Unit& u, int wr, int wc, int fr, int fq) const {
        const bool isb = u.pm >= 64; const int pm = isb ? u.pm - 64 : u.pm, pn = isb ? u.pn - 8 : u.pn;
        const int row0 = pm * 256 + wr * 64 + fr, cl = wc * 32 + 8 * fq;
#pragma unroll
        for (int ai = 0; ai < 2; ++ai) {
            u32x4 gwv[4][2], tvv[4][2];
#pragma unroll
            for (int m = 0; m < 4; ++m)
#pragma unroll
                for (int bj = 0; bj < 2; ++bj) { const int row = row0 + ai * 128 + m * 16, col = pn * 256 + bj * 128 + cl;
                    gwv[m][bj] = *(const u32x4*)(gates + (size_t)row * 4096 + (isb ? 2048 : 0) + col);
                    if (isb) tvv[m][bj] = *(const u32x4*)(T + (size_t)row * 2048 + col); }
#pragma unroll
            for (int m = 0; m < 4; ++m) { const int row = row0 + ai * 128 + m * 16;
#pragma unroll
                for (int bj = 0; bj < 2; ++bj) { const int col = pn * 256 + bj * 128 + cl;
                    const u32x4 gw = gwv[m][bj];
                    const f32x4 g0 = {bflo(gw.x), bfhi(gw.x), bflo(gw.y), bfhi(gw.y)}, g1 = {bflo(gw.z), bfhi(gw.z), bflo(gw.w), bfhi(gw.w)};
                    if (!isb) st8(T + (size_t)row * 2048 + col, g0 * acc[ai][bj][m][0], g1 * acc[ai][bj][m][1]);
                    else { const u32x4 tw = tvv[m][bj];
                        const f32x4 a0 = {bflo(tw.x), bfhi(tw.x), bflo(tw.y), bfhi(tw.y)}, a1 = {bflo(tw.z), bfhi(tw.z), bflo(tw.w), bfhi(tw.w)};
                        st8(mixed + (size_t)row * 2048 + col, a0 + g0 * acc[ai][bj][m][0], a1 + g1 * acc[ai][bj][m][1]); } } } }
    }
};
struct BranchOrder {
    pg8::StaticOrder so;
    __device__ void init(int G, int c) { so.init(S_, DM, G, c); }
    __device__ bool next(int i, Unit& u) const { if (!so.next(i >> 1, u)) return false; if (i & 1) { u.pm += 64; u.pn += 8; } return true; }
    __device__ __forceinline__ void a_ready(const Unit&) const {}
    __device__ __forceinline__ void done(const Unit&) const {}
};
struct EpiOut {
    static constexpr bool PERM = true, AFTER_DRAIN = false;
    const float* x; float* hf; bf16_t* hb; float* ssq_h;
    __device__ __forceinline__ void operator()(const f32x4 (&acc)[2][2][4][2], const Unit& u, int wr, int wc, int fr, int fq) const {
        const int pn = u.pn, row0 = u.pm * 256 + wr * 64 + fr, cl = wc * 32 + 8 * fq;
#pragma unroll
        for (int ai = 0; ai < 2; ++ai) {
            f32x4 xv0[4][2], xv1[4][2];
#pragma unroll
            for (int m = 0; m < 4; ++m)
#pragma unroll
                for (int bj = 0; bj < 2; ++bj) { const size_t o = (size_t)(row0 + ai * 128 + m * 16) * 2048 + pn * 256 + bj * 128 + cl; xv0[m][bj] = *(const f32x4*)(x + o); xv1[m][bj] = *(const f32x4*)(x + o + 4); }
#pragma unroll
            for (int m = 0; m < 4; ++m) { const int row = row0 + ai * 128 + m * 16; float s = 0.f;
#pragma unroll
                for (int bj = 0; bj < 2; ++bj) { const size_t o = (size_t)row * 2048 + pn * 256 + bj * 128 + cl;
                    const f32x4 h0 = xv0[m][bj] + acc[ai][bj][m][0], h1 = xv1[m][bj] + acc[ai][bj][m][1];
                    *(f32x4*)(hf + o) = h0; *(f32x4*)(hf + o + 4) = h1; st8(hb + o, h0, h1); s += sq4(h0) + sq4(h1); }
                s += __shfl_xor(s, 16); s += __shfl_xor(s, 32);
                if (fq == 0) atomicAdd(ssq_h + row, s); } }
    }
};
struct EpiGU {
    static constexpr bool PERM = true, AFTER_DRAIN = false;
    bf16_t* act; const float* ssq_h;
    __device__ __forceinline__ void operator()(const f32x4 (&acc)[2][2][4][2], const Unit& u, int wr, int wc, int fr, int fq) const {
        const int pn = u.pn, row0 = u.pm * 256 + wr * 64 + fr, cl = wc * 32 + 8 * fq;
        float sq[2][4];
#pragma unroll
        for (int ai = 0; ai < 2; ++ai)
#pragma unroll
            for (int m = 0; m < 4; ++m) sq[ai][m] = ssq_h[row0 + ai * 128 + m * 16];
#pragma unroll
        for (int ai = 0; ai < 2; ++ai)
#pragma unroll
            for (int m = 0; m < 4; ++m) { const int row = row0 + ai * 128 + m * 16; const float r = rstd_of(sq[ai][m], 1.0f / 2048.0f);
                f32x4 o0, o1;
#pragma unroll
                for (int i = 0; i < 4; ++i) { const float g0 = acc[ai][0][m][0][i] * r, g1 = acc[ai][0][m][1][i] * r;
                    o0[i] = g0 * sigm(g0) * (acc[ai][1][m][0][i] * r); o1[i] = g1 * sigm(g1) * (acc[ai][1][m][1][i] * r); }
                st8(act + (size_t)row * DFF + pn * 128 + cl, o0, o1); }
    }
};
struct EpiDown {
    static constexpr bool PERM = true, AFTER_DRAIN = false;
    const float* hf; float* out; float* ssq_o;
    __device__ __forceinline__ void operator()(const f32x4 (&acc)[2][2][4][2], const Unit& u, int wr, int wc, int fr, int fq) const {
        const int pn = u.pn, row0 = u.pm * 256 + wr * 64 + fr, cl = wc * 32 + 8 * fq;
#pragma unroll
        for (int ai = 0; ai < 2; ++ai) {
            f32x4 xv0[4][2], xv1[4][2];
#pragma unroll
            for (int m = 0; m < 4; ++m)
#pragma unroll
                for (int bj = 0; bj < 2; ++bj) { const size_t o = (size_t)(row0 + ai * 128 + m * 16) * 2048 + pn * 256 + bj * 128 + cl; xv0[m][bj] = *(const f32x4*)(hf + o); xv1[m][bj] = *(const f32x4*)(hf + o + 4); }
#pragma unroll
            for (int m = 0; m < 4; ++m) { const int row = row0 + ai * 128 + m * 16; float s = 0.f;
#pragma unroll
                for (int bj = 0; bj < 2; ++bj) { const size_t o = (size_t)row * 2048 + pn * 256 + bj * 128 + cl;
                    const f32x4 h0 = xv0[m][bj] + acc[ai][bj][m][0], h1 = xv1[m][bj] + acc[ai][bj][m][1];
                    *(f32x4*)(out + o) = h0; *(f32x4*)(out + o + 4) = h1; s += sq4(h0) + sq4(h1); }
                s += __shfl_xor(s, 16); s += __shfl_xor(s, 32);
                if (fq == 0) atomicAdd(ssq_o + row, s); } }
    }
};

namespace att {
constexpr int SHM_V = 16384, SHM_K = 16384, SHM_K2 = 64 * 144;
constexpr int OFF_K = 0, OFF_K2 = 2 * SHM_K, OFF_V = OFF_K2 + 2 * SHM_K2, OFF_WS = OFF_V + 2 * SHM_V, OFF_MISC = OFF_WS + 8 * 64 * 4, OFF_Q2 = OFF_MISC + 1024;
#define KSWZ(row, colB) ((row) * 256 + ((colB) ^ (((row) & 7) << 4)))
#define K2SWZ(row, colB) ((row) * 144 + (colB))
#define SBAR() __builtin_amdgcn_sched_barrier(0)
__device__ __forceinline__ int v_st(int k, int c) { const int kk = (k & ~0xC) | ((k & 4) << 1) | ((k & 8) >> 1); return ((kk >> 3) * 4 + (c >> 5)) * 512 + ((kk & 7) * 32 + (c & 31)) * 2; }
__device__ __forceinline__ int v_rd_base(int lane) { return ((lane & 3) << 3) | (((lane >> 2) & 3) << 6) | (((lane >> 4) & 1) << 5) | (((lane >> 5) & 1) << 8); }
constexpr int v_rd_off(int d0, int ks, int half) { return d0 * 512 + ks * 4096 + half * 2048; }
__device__ __forceinline__ int crow(int r, int hi) { return (r & 3) + 8 * (r >> 2) + 4 * hi; }
__device__ __forceinline__ unsigned cvtpk(float lo, float hi) { return pg8::cvt_pk_bf16(lo, hi); }
__device__ __forceinline__ void mask_tile(f32x16& p0, f32x16& p1, int dq) {
    const float NEG = -__builtin_inff();
#pragma unroll
    for (int r = 0; r < 16; ++r) { const int c = (r & 3) + 8 * (r >> 2);
        if (dq - c < 0) p0[r] = NEG;
        if (dq - c - 32 < 0) p1[r] = NEG; }
}
__device__ __forceinline__ void partialSM(f32x16& p0, f32x16& p1, float& m_reg, float& mn, float& alpha, const float C2) {
    float pmax = p0[0];
#pragma unroll
    for (int r = 1; r < 16; ++r) pmax = fmaxf(pmax, p0[r]);
#pragma unroll
    for (int r = 0; r < 16; ++r) pmax = fmaxf(pmax, p1[r]);
    { auto rr = __builtin_amdgcn_permlane32_swap(__float_as_uint(pmax), __float_as_uint(pmax), false, false);
      pmax = fmaxf(__uint_as_float(rr[0]), __uint_as_float(rr[1])); }
    if (__builtin_expect(__all((pmax - m_reg) * C2 <= 11.5f), 1)) { mn = m_reg; alpha = 1.f; }
    else { mn = fmaxf(m_reg, pmax); alpha = __builtin_amdgcn_exp2f((m_reg - mn) * C2); m_reg = mn; }
    const float mnL = -mn * C2;
#pragma unroll
    for (int r = 0; r < 16; ++r) p0[r] = fmaf(p0[r], C2, mnL);
#pragma unroll
    for (int r = 0; r < 16; ++r) p1[r] = fmaf(p1[r], C2, mnL);
#pragma unroll
    for (int r = 0; r < 16; ++r) p0[r] = __builtin_amdgcn_exp2f(p0[r]);
}
__device__ __forceinline__ void finishSM(f32x16& p0, f32x16& p1, float alpha, float& l_reg, bf16x8& pa0, bf16x8& pa1, bf16x8& pa2, bf16x8& pa3) {
#pragma unroll
    for (int r = 0; r < 16; ++r) p1[r] = __builtin_amdgcn_exp2f(p1[r]);
    float ps = 0;
#pragma unroll
    for (int r = 0; r < 16; ++r) ps += p0[r];
#pragma unroll
    for (int r = 0; r < 16; ++r) ps += p1[r];
    { auto rr = __builtin_amdgcn_permlane32_swap(__float_as_uint(ps), __float_as_uint(ps), false, false);
      ps = __uint_as_float(rr[0]) + __uint_as_float(rr[1]); }
    l_reg = l_reg * alpha + ps;
#define PK4(P, B_, OUT) do { unsigned a0 = cvtpk(P[B_+0], P[B_+1]), a1 = cvtpk(P[B_+2], P[B_+3]);                          \
        unsigned b0 = cvtpk(P[B_+4], P[B_+5]), b1 = cvtpk(P[B_+6], P[B_+7]);                                             \
        auto r0 = __builtin_amdgcn_permlane32_swap(a0, b0, false, false); auto r1 = __builtin_amdgcn_permlane32_swap(a1, b1, false, false); \
        u32x4 w = {r0[0], r1[0], r0[1], r1[1]}; OUT = *reinterpret_cast<bf16x8*>(&w); } while (0)
    PK4(p0, 0, pa0); PK4(p0, 8, pa1); PK4(p1, 0, pa2); PK4(p1, 8, pa3);
#undef PK4
}
__device__ __forceinline__ bf16x8 pack8v(const f32x16& p, int b) { u32x4 w = {cvtpk(p[b], p[b + 1]), cvtpk(p[b + 2], p[b + 3]), cvtpk(p[b + 4], p[b + 5]), cvtpk(p[b + 6], p[b + 7])}; return *reinterpret_cast<bf16x8*>(&w); }
template <int KB, bool MLA>
__device__ __forceinline__ void qkt(f32x16& p0, f32x16& p1, const char* lds, int r32, int hi, const bf16x8* qr, const char* q2p) {
    p0 = f32x16{}; p1 = f32x16{};
    const char* kb[4];
#pragma unroll
    for (int dd = 0; dd < 4; ++dd) kb[dd] = lds + OFF_K + KB * SHM_K + KSWZ(r32, (dd * 16 + hi * 8) * 2);
#pragma unroll
    for (int d0 = 0; d0 < 8; ++d0) { const char* a = kb[d0 & 3] + (d0 >> 2) * 128;
        bf16x8 b0 = *reinterpret_cast<const bf16x8*>(a);
        bf16x8 b1 = *reinterpret_cast<const bf16x8*>(a + 32 * 256);
        p0 = __builtin_amdgcn_mfma_f32_32x32x16_bf16(b0, qr[d0], p0, 0, 0, 0);
        p1 = __builtin_amdgcn_mfma_f32_32x32x16_bf16(b1, qr[d0], p1, 0, 0, 0); }
    if constexpr (MLA) {
#pragma unroll
        for (int d0 = 0; d0 < 4; ++d0) { const char* a = lds + OFF_K2 + KB * SHM_K2 + K2SWZ(r32, (d0 * 16 + hi * 8) * 2);
            bf16x8 b0 = *reinterpret_cast<const bf16x8*>(a);
            bf16x8 b1 = *reinterpret_cast<const bf16x8*>(a + 32 * 144);
            const bf16x8 qf = *reinterpret_cast<const bf16x8*>(q2p + d0 * 1024);
            p0 = __builtin_amdgcn_mfma_f32_32x32x16_bf16(b0, qf, p0, 0, 0, 0);
            p1 = __builtin_amdgcn_mfma_f32_32x32x16_bf16(b1, qf, p1, 0, 0, 0); }
    }
    constexpr int NR = MLA ? 28 : 16, NM = MLA ? 24 : 16, AHEAD = 8;
    __builtin_amdgcn_sched_group_barrier(0x100, AHEAD, 0);
#pragma unroll
    for (int i = 0; i < NR - AHEAD; ++i) { __builtin_amdgcn_sched_group_barrier(0x008, 1, 0); __builtin_amdgcn_sched_group_barrier(0x100, 1, 0); }
    __builtin_amdgcn_sched_group_barrier(0x008, NM - (NR - AHEAD), 0);
}
typedef s16x4 __attribute__((address_space(3)))* lds_s16x4_p;
template <int VB>
__device__ __forceinline__ void pv_tile(f32x16* o, const __attribute__((address_space(3))) char* vbp, bf16x8 pa0, bf16x8 pa1, bf16x8 pa2, bf16x8 pa3) {
#define TRRD(off) __builtin_amdgcn_ds_read_tr16_b64_v4i16((lds_s16x4_p)(vbp + (off)))
#define PV_D0(d0) do { constexpr int b_ = VB * SHM_V + v_rd_off(d0, 0, 0);                                                                   \
        const s16x4 l0 = TRRD(b_), h0 = TRRD(b_ + 2048), l1 = TRRD(b_ + 4096), h1 = TRRD(b_ + 6144), l2 = TRRD(b_ + 8192), h2 = TRRD(b_ + 10240), l3 = TRRD(b_ + 12288), h3 = TRRD(b_ + 14336); \
        o[d0] = __builtin_amdgcn_mfma_f32_32x32x16_bf16(pa0, (bf16x8){l0[0], l0[1], l0[2], l0[3], h0[0], h0[1], h0[2], h0[3]}, o[d0], 0, 0, 0);   \
        o[d0] = __builtin_amdgcn_mfma_f32_32x32x16_bf16(pa1, (bf16x8){l1[0], l1[1], l1[2], l1[3], h1[0], h1[1], h1[2], h1[3]}, o[d0], 0, 0, 0);   \
        o[d0] = __builtin_amdgcn_mfma_f32_32x32x16_bf16(pa2, (bf16x8){l2[0], l2[1], l2[2], l2[3], h2[0], h2[1], h2[2], h2[3]}, o[d0], 0, 0, 0);   \
        o[d0] = __builtin_amdgcn_mfma_f32_32x32x16_bf16(pa3, (bf16x8){l3[0], l3[1], l3[2], l3[3], h3[0], h3[1], h3[2], h3[3]}, o[d0], 0, 0, 0); } while (0)
    PV_D0(0); PV_D0(1); PV_D0(2); PV_D0(3);
#undef PV_D0
#undef TRRD
}

struct AttnIO { const bf16_t* Q; const bf16_t* Q2; const bf16_t* K; const bf16_t* K2; const bf16_t* V; bf16_t* O; long long d2; float2* ml; const unsigned short* list; };

template <int MODE, int VAR = 0>
__device__ __forceinline__ void attn_item(char* lds, const AttnIO& io, int h, int qb, int cbase, int nvalid, float C2) {
    constexpr bool MLA = (MODE == 0);
    int tid_ = threadIdx.x; asm volatile("" : "+v"(tid_));
    const int tid = tid_, wid = __builtin_amdgcn_readfirstlane(tid >> 6), lane = tid & 63, r32 = lane & 31, hi = lane >> 5;
    const int q0 = qb * 256, qlo = q0 + wid * 32;
    int row = qlo + r32, ent = 0; bool valid = true;
    if constexpr (MODE == 2) { const int e = wid * 32 + r32; valid = e < nvalid; ent = (int)io.list[(size_t)cbase + (valid ? e : 0)]; row = ent & 0x3fff; }
    const int qm = row - 4 * hi;
    float* wsf = (float*)(lds + OFF_WS) + wid * 64; float* li_l = wsf; float* al_l = wsf + 32;
    bf16x8 qr[8]; const char* q2p = lds + OFF_Q2 + wid * 4096 + lane * 16;
#pragma unroll
    for (int d0 = 0; d0 < 8; ++d0) qr[d0] = *(const bf16x8*)(io.Q + (size_t)row * 1024 + h * 128 + d0 * 16 + hi * 8);
    if constexpr (MLA) {
#pragma unroll
        for (int d0 = 0; d0 < 4; ++d0) *(bf16x8*)(lds + OFF_Q2 + wid * 4096 + d0 * 1024 + lane * 16) = *(const bf16x8*)(io.Q2 + (size_t)row * 512 + h * 64 + d0 * 16 + hi * 8);
    }
    const int NT = MLA ? 4 * (qb + 1) : 4, kb0 = MLA ? 0 : q0;
    const int sr = tid >> 4, sc = (tid & 15) * 8, vst0 = v_st(sr, sc), vst1 = v_st(32 + sr, sc), kws = KSWZ(sr, sc * 2);
    const int s2r = tid >> 3, s2c = (tid & 7) * 8, k2ws = K2SWZ(s2r, s2c * 2);
    const __attribute__((address_space(3))) char* vbp = (const __attribute__((address_space(3))) char*)(unsigned)((int)(uintptr_t)(lds) + OFF_V + v_rd_base(lane));
    const bf16_t* Kh = io.K + h * 128 + sc; const bf16_t* Vh = io.V + h * 128 + sc; const bf16_t* K2h = MLA ? io.K2 + s2c : nullptr;
    float m_reg = -1e30f, l_reg = 0.f; f32x16 o[4] = {};
#define KEY0(t) (kb0 + (t) * 64)
#define LOADS_K(kk_) do { st_k0 = *(const bf16x8*)(Kh + (size_t)((kk_) + sr) * 1024); st_k1 = *(const bf16x8*)(Kh + (size_t)((kk_) + 32 + sr) * 1024);      \
                       if constexpr (MLA) st_k2 = *(const bf16x8*)(K2h + (size_t)((kk_) + s2r) * 64); } while (0)
#define LOADS_V(kk_) do { st_v0 = *(const bf16x8*)(Vh + (size_t)((kk_) + sr) * 1024); st_v1 = *(const bf16x8*)(Vh + (size_t)((kk_) + 32 + sr) * 1024); } while (0)
#define WRITES_K(bf) do { *(bf16x8*)(lds + OFF_K + (bf) * SHM_K + kws) = st_k0; *(bf16x8*)(lds + OFF_K + (bf) * SHM_K + kws + 32 * 256) = st_k1;           \
                        if constexpr (MLA) *(bf16x8*)(lds + OFF_K2 + (bf) * SHM_K2 + k2ws) = st_k2; } while (0)
#define WRITES_V(bf) do { *(bf16x8*)(lds + OFF_V + (bf) * SHM_V + vst0) = st_v0; *(bf16x8*)(lds + OFF_V + (bf) * SHM_V + vst1) = st_v1; } while (0)
#define RESC(a) do { if (__any((a) < 1.f)) { if (hi == 0) al_l[r32] = (a); asm volatile("s_waitcnt lgkmcnt(0)" ::: "memory");              \
                     for (int d_ = 0; d_ < 4; ++d_) for (int r = 0; r < 16; ++r) o[d_][r] *= al_l[crow(r, hi)]; } } while (0)
#define BAR() do { asm volatile("s_waitcnt lgkmcnt(0)" ::: "memory"); __builtin_amdgcn_s_barrier(); asm volatile("" ::: "memory"); } while (0)
    const int grp = wid >> 2;
    f32x16 p0, p1; bf16x8 pa0, pa1, pa2, pa3; float mn, al;
    bf16x8 st_k0, st_k1, st_v0, st_v1, st_k2;
#define ATT_STEP(t_, KB) do { const int t__ = (t_); const int k0__ = KEY0(t__);                                                                       \
        if (grp == 0) { if (t__ + 1 < NT) LOADS_K(KEY0(t__ + 1)); LOADS_V(k0__); } SBAR();                                                           \
        if (t__ > 0) pv_tile<(KB) ^ 1>(o, vbp, pa0, pa1, pa2, pa3); SBAR();                                                                          \
        qkt<KB, MLA>(p0, p1, lds, r32, hi, qr, q2p);                                                                                                 \
        if constexpr (MODE != 2) { if (k0__ + 63 > qlo) mask_tile(p0, p1, qm - k0__); }                                                              \
        SBAR(); if (grp == 1) { if (t__ + 1 < NT) WRITES_K((KB) ^ 1); WRITES_V(KB); }                                                                \
        BAR();                                                                                                                                       \
        if (grp == 1) { if (t__ + 2 < NT) LOADS_K(KEY0(t__ + 2)); if (t__ + 1 < NT) LOADS_V(KEY0(t__ + 1)); } SBAR();                                \
        partialSM(p0, p1, m_reg, mn, al, C2); finishSM(p0, p1, al, l_reg, pa0, pa1, pa2, pa3); RESC(al);                                            \
        SBAR(); if (grp == 0) { if (t__ + 1 < NT) WRITES_K((KB) ^ 1); WRITES_V(KB); }                                                                \
        BAR(); } while (0)
    { const int k00 = KEY0(0); LOADS_K(k00); WRITES_K(0); }
    if (grp == 1) { LOADS_K(KEY0(1)); LOADS_V(KEY0(0)); }
    BAR();
    if (grp == 1) BAR();
    for (int t = 0; t < NT; t += 2) { ATT_STEP(t, 0); ATT_STEP(t + 1, 1); }
    pv_tile<1>(o, vbp, pa0, pa1, pa2, pa3);
    BAR();
    if (grp == 0) BAR();
    int* ri_l = (int*)al_l;
    if (hi == 0) { li_l[r32] = l_reg; if constexpr (MODE == 2) ri_l[r32] = valid ? ent : -1; }
    asm volatile("s_waitcnt lgkmcnt(0)" ::: "memory");
    if constexpr (MODE != 0) { if (hi == 0 && valid) io.ml[((size_t)row * 8 + h) * 4 + (MODE == 1 ? 3 : (ent >> 14))] = make_float2(m_reg * C2, l_reg); }
#pragma unroll
    for (int r = 0; r < 16; ++r) { const int orow = crow(r, hi); const float rl = 1.0f / li_l[orow];
        bf16_t* Ow; bool st = true;
        if constexpr (MODE == 2) { const int info = ri_l[orow]; st = info >= 0; const int sl = info >> 14; Ow = io.O + ((long long)sl * (16384LL * 1024) + (sl == 2 ? io.d2 : 0LL)) + (size_t)(info & 0x3fff) * 1024 + h * 128; }
        else Ow = io.O + (size_t)(qlo + orow) * 1024 + h * 128;
#pragma unroll
        for (int d0 = 0; d0 < 4; ++d0) { const float v = o[d0][r] * rl; const float vn = __shfl_xor(v, 1);
            if ((VAR == 0 || C2 < 0.f) && st && (r32 & 1) == 0) *(unsigned*)(Ow + d0 * 32 + r32) = cvtpk(v, vn); } }
    BAR();
#undef KEY0
#undef LOADS_K
#undef LOADS_V
#undef WRITES_K
#undef WRITES_V
#undef RESC
#undef ATT_STEP
#undef BAR
}
}

struct WJob { const float* s1; const float* s2; const float* gain; bf16_t* dst; int ld, K, map, ntn; };
__device__ __forceinline__ const float* wsrc(int map, const float* s1, const float* s2, int n) {
    if (map == 0) return s1 + n;
    if (map == 1) {
        if (n < 2048) { const int hb = n & ~127, c = n & 127; const int d = c < 32 ? ((c >> 1) + 16 * (c & 1)) : c; return s1 + hb + d; }
        if (n < 3840) return s1 + n;
        if (n < 3904) { const int c = n - 3840; return s1 + 3840 + (c >> 1) + 32 * (c & 1); }
        if (n < 4096) return nullptr;
        return s1 + 3904 + (n - 4096); }
    if (map == 2) {
        if (n < 1024) return s1 + (n >> 7) * 192 + (n & 127);
        const int c = n - 1024, h = c >> 6, cc = c & 63; return s1 + h * 192 + 128 + (cc >> 1) + 32 * (cc & 1); }
    { const int t = n >> 8, r = n & 255; return r < 128 ? s1 + 128 * t + r : s2 + 128 * t + (r - 128); }
}
__device__ __forceinline__ bool wtile_load(const WJob& J, int tn, int tk, int lane, float (&v)[64]) {
    const float* sp = wsrc(J.map, J.s1, J.s2, tn * 64 + lane); const bool has = sp != nullptr; if (!has) sp = J.s1;
    const int k0 = tk * 64;
#pragma unroll
    for (int i = 0; i < 64; ++i) v[i] = __builtin_nontemporal_load(sp + (size_t)(k0 + i) * J.ld);
    return has;
}
__device__ __forceinline__ void wtile_store(const WJob& J, int tn, int tk, int lane, float (&v)[64], bool has) {
    const int k0 = tk * 64;
    if (J.gain) {
#pragma unroll
        for (int i = 0; i < 64; ++i) v[i] *= J.gain[k0 + i]; }
    if (!has) {
#pragma unroll
        for (int i = 0; i < 64; ++i) v[i] = 0.f; }
    bf16_t* d = J.dst + (size_t)(tn * 64 + lane) * J.K + k0;
#pragma unroll
    for (int i = 0; i < 8; ++i) { u32x4 w; w.x = cvt_pk_bf16(v[8 * i], v[8 * i + 1]); w.y = cvt_pk_bf16(v[8 * i + 2], v[8 * i + 3]); w.z = cvt_pk_bf16(v[8 * i + 4], v[8 * i + 5]); w.w = cvt_pk_bf16(v[8 * i + 6], v[8 * i + 7]);
        *(u32x4*)(d + 8 * i) = w; }
}
__device__ __forceinline__ WJob wjob_of(const Params& P, unsigned char* ws, int t, int& lt) {
    if (t < 4096) { lt = t; return WJob{P.w_in, nullptr, nullptr, (bf16_t*)(ws + WS_WIN), 8000, 2048, 1, 128}; }
    if (t < 4288) { lt = t - 4096; return WJob{P.w_uq, nullptr, P.q_norm, (bf16_t*)(ws + WS_WUQ), 1536, 512, 2, 24}; }
    if (t < 4416) { lt = t - 4288; return WJob{P.w_ukv, nullptr, P.kv_norm, (bf16_t*)(ws + WS_WUKV), 2048, 256, 0, 32}; }
    if (t < 4928) { lt = t - 4416; return WJob{P.w_ba, nullptr, nullptr, (bf16_t*)(ws + WS_WBR), 2048, 1024, 0, 32}; }
    if (t < 5440) { lt = t - 4928; return WJob{P.w_bb, nullptr, nullptr, (bf16_t*)(ws + WS_WBR) + (size_t)2048 * 1024, 2048, 1024, 0, 32}; }
    if (t < 6464) { lt = t - 5440; return WJob{P.w_out, nullptr, nullptr, (bf16_t*)(ws + WS_WOUT), 2048, 2048, 0, 32}; }
    if (t < 12096) { lt = t - 6464; return WJob{P.w_gate, P.w_up, P.ffn_norm, (bf16_t*)(ws + WS_WGU), 5632, 2048, 3, 176}; }
    lt = t - 12096; return WJob{P.w_down, nullptr, nullptr, (bf16_t*)(ws + WS_WDN), 2048, 5632, 0, 32};
}
__device__ __forceinline__ void sincos_rev(float ang, float& c, float& s) {
    const double rev = (double)ang * 0.15915494309189535; const float fr = (float)(rev - __builtin_rint(rev));
    c = __builtin_amdgcn_cosf(fr); s = __builtin_amdgcn_sinf(fr); }
__device__ __forceinline__ void phase0(const Params& P, char* lds) {
    const int tid = threadIdx.x, lane = tid & 63, wid = tid >> 6, gtid = blockIdx.x * 512 + tid, gsz = gridDim.x * 512;
    unsigned char* ws = P.ws;
    { float* z = (float*)(ws + WS_KMS); for (int i = gtid; i < 65536 + 65536 + 1024; i += gsz) z[i] = 0.f; }
    { float* csa = (float*)(ws + WS_CSA); float* csb = (float*)(ws + WS_CSB);
#define ROPE_TAB(T_, W_, F_, B_) do { _Pragma("unroll") for (int q_ = 0; q_ < 8; ++q_) { float c_, s_; sincos_rev(pf * F_[(B_) + q_], c_, s_);               \
          T_[(size_t)row * (W_) + 2 * ((B_) + q_)] = c_; T_[(size_t)row * (W_) + 2 * ((B_) + q_) + 1] = s_; } } while (0)
      for (int it = gtid; it < S_ * 6; it += gsz) { const int row = it / 6, g = it - row * 6; const float pf = (float)P.pos[row];
          switch (g) { case 0: ROPE_TAB(csa, 32, P.invf_a, 0); break; case 1: ROPE_TAB(csa, 32, P.invf_a, 8); break;
                       case 2: ROPE_TAB(csb, 64, P.invf_b, 0); break; case 3: ROPE_TAB(csb, 64, P.invf_b, 8); break;
                       case 4: ROPE_TAB(csb, 64, P.invf_b, 16); break; default: ROPE_TAB(csb, 64, P.invf_b, 24); break; } }
#undef ROPE_TAB
    }
    { bf16_t* xn = (bf16_t*)(ws + WS_ACT + A_XN);
      for (int row = blockIdx.x * 8 + wid; row < S_; row += gridDim.x * 8) { const f32x4* xr = (const f32x4*)(P.x + (size_t)row * DM); f32x4 v[8]; float ss = 0.f;
#pragma unroll
          for (int i = 0; i < 8; ++i) { v[i] = __builtin_nontemporal_load(xr + lane + 64 * i); ss += sq4(v[i]); }
#pragma unroll
          for (int off = 32; off >= 1; off >>= 1) ss += __shfl_xor(ss, off);
          const float r = rstd_of(ss, 1.0f / 2048.0f);
#pragma unroll
          for (int i = 0; i < 8; ++i) { const f32x4 g = ((const f32x4*)P.attn_norm)[lane + 64 * i]; const f32x4 y = v[i] * r * g;
              uint2 w; w.x = cvt_pk_bf16(y[0], y[1]); w.y = cvt_pk_bf16(y[2], y[3]); ((uint2*)(xn + (size_t)row * DM))[lane + 64 * i] = w; } } }
    {
      const int nw = gridDim.x * 8; int t = nw - 1 - (blockIdx.x * 8 + wid);
      if (t < 14912) { int lt; WJob J = wjob_of(P, ws, t, lt); float v[64]; bool has = wtile_load(J, lt % J.ntn, lt / J.ntn, lane, v);
          for (;;) { const int t2 = t + nw; int lt2 = 0; WJob J2 = J; float w[64]; bool has2 = false;
              if (t2 < 14912) { J2 = wjob_of(P, ws, t2, lt2); has2 = wtile_load(J2, lt2 % J2.ntn, lt2 / J2.ntn, lane, w); }
              wtile_store(J, lt % J.ntn, lt / J.ntn, lane, v, has);
              if (t2 >= 14912) break;
#pragma unroll
              for (int i = 0; i < 64; ++i) v[i] = w[i];
              J = J2; lt = lt2; has = has2; t = t2; } } }
}
constexpr int L_TRI = 256 * 2016;
__host__ __device__ __forceinline__ int l_tri(int j) { return 256 * (63 * j - (j * (j - 1)) / 2); }
__device__ __forceinline__ void moba_gate(const Params& P, char* lds) {
    const int tid = threadIdx.x; float* km = (float*)lds; unsigned char* ws = P.ws;
    const float* kms = (const float*)(ws + WS_KMS); const bf16_t* qa = (const bf16_t*)(ws + WS_ACT + A_QA); unsigned* lcnt = (unsigned*)(ws + WS_CTL) + 256; unsigned short* list = (unsigned short*)(ws + WS_ACT + A_LIST);
    for (int item = blockIdx.x; item < 256; item += gridDim.x) { const int h = item & 7, pp = item >> 3;
        __syncthreads();
        for (int i = tid; i < 8192; i += 512) km[i] = kms[h * 8192 + i] * (1.0f / 256.0f);
        __syncthreads();
        const int row = tid < 256 ? pp * 256 + tid : (63 - pp) * 256 + (tid - 256), blk = row >> 8, nblk = __builtin_amdgcn_readfirstlane(blk);
        const u32x4* qp = (const u32x4*)(qa + (size_t)row * 1024 + h * 128); u32x4 q[16];
#pragma unroll
        for (int i = 0; i < 16; ++i) q[i] = qp[i];
        float b1 = -__builtin_inff(), b2 = b1, b3 = b1; int i1 = 0, i2 = 0, i3 = 0;
        for (int n = 0; n < nblk; ++n) { const f32x4* kr = (const f32x4*)(km + n * 128); float a0 = 0.f, a1 = 0.f;
#pragma unroll
            for (int i = 0; i < 16; ++i) { const f32x4 ka = kr[2 * i], kb = kr[2 * i + 1]; const u32x4 qq = q[i];
                a0 += bflo(qq.x) * ka[0] + bfhi(qq.x) * ka[1] + bflo(qq.y) * ka[2] + bfhi(qq.y) * ka[3];
                a1 += bflo(qq.z) * kb[0] + bfhi(qq.z) * kb[1] + bflo(qq.w) * kb[2] + bfhi(qq.w) * kb[3]; }
            const float g = a0 + a1;
            if (g > b1) { b3 = b2; i3 = i2; b2 = b1; i2 = i1; b1 = g; i1 = n; }
            else if (g > b2) { b3 = b2; i3 = i2; b2 = g; i2 = n; }
            else if (g > b3) { b3 = g; i3 = n; } }
        if (blk >= 1) { const unsigned p = atomicAdd(lcnt + h * 64 + i1, 1u); list[(size_t)h * L_TRI + l_tri(i1) + p] = (unsigned short)(row); }
        if (blk >= 2) { const unsigned p = atomicAdd(lcnt + h * 64 + i2, 1u); list[(size_t)h * L_TRI + l_tri(i2) + p] = (unsigned short)(row | (1 << 14)); }
        if (blk >= 3) { const unsigned p = atomicAdd(lcnt + h * 64 + i3, 1u); list[(size_t)h * L_TRI + l_tri(i3) + p] = (unsigned short)(row | (2 << 14)); } }
}
__device__ __forceinline__ void grid_bar(unsigned* cnt, unsigned& target, unsigned G) {
    asm volatile("s_waitcnt vmcnt(0)" ::: "memory");
    __syncthreads();
    target += G;
    if (threadIdx.x == 0) {
        __builtin_amdgcn_fence(__ATOMIC_RELEASE, "agent");
        asm volatile("s_waitcnt vmcnt(0)" ::: "memory");
        __hip_atomic_fetch_add(cnt, 1u, __ATOMIC_RELAXED, __HIP_MEMORY_SCOPE_AGENT);
        while (__hip_atomic_load(cnt, __ATOMIC_RELAXED, __HIP_MEMORY_SCOPE_AGENT) < target) __builtin_amdgcn_s_sleep(1);
        __builtin_amdgcn_fence(__ATOMIC_ACQUIRE, "agent");
        asm volatile("s_waitcnt vmcnt(0)" ::: "memory");
    }
    __syncthreads();
}
constexpr int LDS_BYTES = pg8::STAGE_BYTES;
__global__ void __launch_bounds__(512, 2) hybrid_fwd(Params P) {
    extern __shared__ __attribute__((aligned(16))) unsigned char lds_raw[];
    char* lds = (char*)lds_raw; PG8_LAS unsigned char* ldsg = (PG8_LAS unsigned char*)lds_raw;
    unsigned char* ws = P.ws; unsigned char* wa = ws + WS_ACT;
    const int tid = threadIdx.x, G = gridDim.x, c = blockIdx.x;
    const int lo = P.ph_lo, hi = P.ph_hi;
    float* ssq = (float*)(ws + WS_SSQ); float* ssq_q = ssq, * ssq_kv = ssq + S_, * ssq_h = ssq + 2 * S_, * ssq_o = ssq + 3 * S_;
    bf16_t* gates = (bf16_t*)P.out;
#ifndef PHMASK
#define PHMASK 0x3ff
#endif
#define IN(k) (((PHMASK >> (k)) & 1) && lo <= (k) && (k) < hi)
    unsigned bar_target = 0; unsigned* bar_cnt = (unsigned*)(ws + WS_BAR);
#define SEAM(k) do { if (IN(k) && IN((k) + 1)) { if (lo < 0) cg::this_grid().sync(); else grid_bar(bar_cnt, bar_target, (unsigned)G); } } while (0)
#ifndef NREP0
#define NREP0 1
#endif
#ifndef NREP3
#define NREP3 1
#endif
#ifndef NREP7
#define NREP7 1
#endif
    if (IN(0)) for (int rep = 0; rep < NREP0; ++rep) { if (rep) cg::this_grid().sync(); phase0(P, lds); }
    SEAM(0);
    if (IN(1)) {
        pg8::Gemm g{(const bf16_t*)(wa + A_XN), (const bf16_t*)(ws + WS_WIN), S_, 8192, 2048}; pg8::StaticOrder so; so.init(S_, 8192, G, c);
        EpiProj E{(bf16_t*)(wa + A_QA), (bf16_t*)(wa + A_KA), (bf16_t*)(wa + A_VA), (bf16_t*)(wa + A_CQ), (bf16_t*)(wa + A_CKV), (bf16_t*)(wa + A_KRP), gates,
                  (const float*)(ws + WS_CSA), (const float*)(ws + WS_CSB), (float*)(ws + WS_KMS), ssq_q, ssq_kv};
        pg8::gemm_phase<EpiProj, pg8::StaticOrder, false>(ldsg, g, so, E, nullptr);
    }
    SEAM(1);
    if (IN(2)) {
#ifndef NO_G2A
        { pg8::Gemm g{(const bf16_t*)(wa + A_CQ), (const bf16_t*)(ws + WS_WUQ), S_, 1536, 512}; pg8::StaticOrder so; so.init(S_, 1536, G, c);
          EpiQ E{(bf16_t*)(wa + A_QN), (bf16_t*)(wa + A_QRP), (const float*)(ws + WS_CSB), ssq_q};
          pg8::gemm_phase<EpiQ, pg8::StaticOrder, false>(ldsg, g, so, E, nullptr); }
#endif
#ifndef NO_G2B
        { int kk = 256; asm volatile("" : "+s"(kk));
          pg8::Gemm g{(const bf16_t*)(wa + A_CKV), (const bf16_t*)(ws + WS_WUKV), S_, 2048, kk}; pg8::StaticOrder so; so.init(S_, 2048, G, c);
          EpiKV E{(bf16_t*)(wa + A_KN), (bf16_t*)(wa + A_VB), ssq_kv};
          pg8::gemm_phase<EpiKV, pg8::StaticOrder, false>(ldsg, g, so, E, nullptr); }
#endif
#ifndef NO_GATE
        moba_gate(P, lds);
#endif
    }
    SEAM(2);
    if (IN(3)) {
        for (int rep = 0; rep < NREP3; ++rep) { if (rep) cg::this_grid().sync();
        unsigned* ctr = (unsigned*)(ws + WS_CTL) + rep * 8; int* itp = (int*)(lds + att::OFF_MISC + 64 + 67 * 4);
        const unsigned* lcnt = (unsigned*)(ws + WS_CTL) + 256; int* pre = (int*)(lds + att::OFF_Q2);
        bf16_t* ya = (bf16_t*)(wa + A_Y);
        att::AttnIO mla{(const bf16_t*)(wa + A_QN), (const bf16_t*)(wa + A_QRP), (const bf16_t*)(wa + A_KN), (const bf16_t*)(wa + A_KRP), (const bf16_t*)(wa + A_VB), ya + (size_t)S_ * 1024, 0LL, nullptr, nullptr};
        att::AttnIO mob{(const bf16_t*)(wa + A_QA), nullptr, (const bf16_t*)(wa + A_KA), nullptr, (const bf16_t*)(wa + A_VA), ya, 0LL, (float2*)(wa + A_ML), nullptr};
        att::AttnIO gat{(const bf16_t*)(wa + A_QA), nullptr, (const bf16_t*)(wa + A_KA), nullptr, (const bf16_t*)(wa + A_VA), (bf16_t*)(wa + A_P0), (long long)((bf16_t*)(ws + WS_WIN) - ((bf16_t*)(wa + A_P0) + 2 * (size_t)S_ * 1024)), (float2*)(wa + A_ML), (const unsigned short*)(wa + A_LIST)};
        unsigned* mq = (unsigned*)(ws + WS_CTL) + 32; unsigned* gq = (unsigned*)(ws + WS_CTL) + 48; const int x0 = (int)(blockIdx.x & 7);
        for (int kx = 0; kx < 8; ++kx) { const int hx = (x0 + kx) & 7;
            for (;;) {
                if (tid == 0) *itp = (int)atomicAdd(mq + hx, 1u);
                __syncthreads();
                const int it = __builtin_amdgcn_readfirstlane(*itp);
                __syncthreads();
                if (it >= 64) break;
                att::attn_item<0>(lds, mla, hx, 63 - it, 0, 0, 1.4426950408889634f * 0.07216878364870323f);
            } }
        { const int hh = tid >> 6, jj = tid & 63; int* tot = pre + 512;
          const int v = jj < 63 ? (int)((lcnt[hh * 64 + jj] + 255u) >> 8) : 0; int inc = v;
#pragma unroll
          for (int off = 1; off < 64; off <<= 1) { const int n_ = __shfl_up(inc, off); if (jj >= off) inc += n_; }
          if (jj == 63) tot[hh] = inc;
          __syncthreads();
          int base = 0;
#pragma unroll
          for (int q = 0; q < 8; ++q) base += (q < hh) ? tot[q] : 0;
          if (jj < 63) pre[hh * 63 + jj] = base + inc - v;
          if (tid == 511) pre[504] = base + inc; }
        __syncthreads();
        { const int ngat = __builtin_amdgcn_readfirstlane(pre[504]);
          for (int it = c; it < ngat; it += G) { int lo_ = 0, hi_ = 503;
              while (lo_ < hi_) { const int mid = (lo_ + hi_ + 1) >> 1; if (__builtin_amdgcn_readfirstlane(pre[mid]) <= it) lo_ = mid; else hi_ = mid - 1; }
              const int pr = lo_, h = pr / 63, j = pr % 63, cch = it - __builtin_amdgcn_readfirstlane(pre[pr]); const int cnt = (int)lcnt[h * 64 + j];
              const int nv = cnt - cch * 256 < 256 ? cnt - cch * 256 : 256;
              att::attn_item<2>(lds, gat, h, j, h * L_TRI + l_tri(j) + cch * 256, nv, 1.4426950408889634f * 0.08838834764831845f); } }
        for (int it = c; it < 512; it += G)
            att::attn_item<1>(lds, mob, it & 7, it >> 3, 0, 0, 1.4426950408889634f * 0.08838834764831845f);
        }
    }
    SEAM(3);
    if (IN(4)) {
        const float2* ml = (const float2*)(wa + A_ML); bf16_t* ya = (bf16_t*)(wa + A_Y);
        const bf16_t* pp0 = (const bf16_t*)(wa + A_P0); const bf16_t* pp1 = (const bf16_t*)(wa + A_P1); const bf16_t* pp2 = (const bf16_t*)(ws + WS_WIN);
        const int lane = tid & 63, wid = tid >> 6, h = lane >> 3;
#define MRG_ACC(a_, b_, w_) do { const float w__ = (w_);                                                                                      \
            c0[0] += w__ * bflo(a_.x); c0[1] += w__ * bfhi(a_.x); c0[2] += w__ * bflo(a_.y); c0[3] += w__ * bfhi(a_.y);                          \
            c1[0] += w__ * bflo(a_.z); c1[1] += w__ * bfhi(a_.z); c1[2] += w__ * bflo(a_.w); c1[3] += w__ * bfhi(a_.w);                          \
            c2[0] += w__ * bflo(b_.x); c2[1] += w__ * bfhi(b_.x); c2[2] += w__ * bflo(b_.y); c2[3] += w__ * bfhi(b_.y);                          \
            c3[0] += w__ * bflo(b_.z); c3[1] += w__ * bfhi(b_.z); c3[2] += w__ * bflo(b_.w); c3[3] += w__ * bfhi(b_.w); } while (0)
#define MRG_LD(ptr, A_, B_) do { A_ = *(const u32x4*)((ptr) + eo); B_ = *(const u32x4*)((ptr) + eo + 8); } while (0)
        for (int row = c * 8 + wid; row < S_; row += G * 8) { const int blk = row >> 8; const size_t mo = ((size_t)row * 8 + h) * 4, eo = (size_t)row * 1024 + lane * 16;
            const float2 s3 = ml[mo + 3]; float2 s0 = make_float2(-1e30f, 0.f), s1 = s0, s2 = s0;
            u32x4 ya_a, ya_b, p0a = {0, 0, 0, 0}, p0b = p0a, p1a = p0a, p1b = p0a, p2a = p0a, p2b = p0a;
            MRG_LD(ya, ya_a, ya_b);
            if (blk >= 1) { s0 = ml[mo]; MRG_LD(pp0, p0a, p0b); } if (blk >= 2) { s1 = ml[mo + 1]; MRG_LD(pp1, p1a, p1b); } if (blk >= 3) { s2 = ml[mo + 2]; MRG_LD(pp2, p2a, p2b); }
            const float M = fmaxf(fmaxf(s3.x, s0.x), fmaxf(s1.x, s2.x));
            const float w3 = s3.y * __builtin_amdgcn_exp2f(s3.x - M), w0 = s0.y * __builtin_amdgcn_exp2f(s0.x - M), w1 = s1.y * __builtin_amdgcn_exp2f(s1.x - M), w2 = s2.y * __builtin_amdgcn_exp2f(s2.x - M);
            f32x4 c0 = {0.f, 0.f, 0.f, 0.f}, c1 = c0, c2 = c0, c3 = c0;
            MRG_ACC(ya_a, ya_b, w3); MRG_ACC(p0a, p0b, w0); MRG_ACC(p1a, p1b, w1); MRG_ACC(p2a, p2b, w2);
            const float inv = 1.0f / (w3 + w0 + w1 + w2);
            st8(ya + eo, c0 * inv, c1 * inv); st8(ya + eo + 8, c2 * inv, c3 * inv); }
#undef MRG_LD
#undef MRG_ACC
    }
    SEAM(4);
    if (IN(5)) {
        pg8::Gemm g{(const bf16_t*)(wa + A_Y), (const bf16_t*)(ws + WS_WBR), 2 * S_, 4096, 1024}; BranchOrder bo; bo.init(G, c);
        EpiBranch E{gates, (bf16_t*)(wa + A_T), (bf16_t*)(wa + A_MIX)};
        pg8::gemm_phase<EpiBranch, BranchOrder, false>(ldsg, g, bo, E, nullptr);
    }
    SEAM(5);
    if (IN(6)) {
        pg8::Gemm g{(const bf16_t*)(wa + A_MIX), (const bf16_t*)(ws + WS_WOUT), S_, 2048, 2048}; pg8::StaticOrder so; so.init(S_, 2048, G, c);
        EpiOut E{P.x, (float*)(wa + A_HF), (bf16_t*)(wa + A_HB), ssq_h};
        pg8::gemm_phase<EpiOut, pg8::StaticOrder, false>(ldsg, g, so, E, nullptr);
    }
    SEAM(6);
    if (IN(7)) {
        pg8::Gemm g{(const bf16_t*)(wa + A_HB), (const bf16_t*)(ws + WS_WGU), S_, 11264, 2048}; pg8::StaticOrder so; so.init(S_, 11264, G, c);
        EpiGU E{(bf16_t*)(wa + A_ACTV), ssq_h};
        for (int rep = 0; rep < NREP7; ++rep) { if (rep) cg::this_grid().sync(); pg8::gemm_phase<EpiGU, pg8::StaticOrder, false>(ldsg, g, so, E, nullptr); }
    }
    SEAM(7);
    if (IN(8)) {
        pg8::Gemm g{(const bf16_t*)(wa + A_ACTV), (const bf16_t*)(ws + WS_WDN), S_, 2048, DFF}; pg8::StaticOrder so; so.init(S_, 2048, G, c);
        EpiDown E{(const float*)(wa + A_HF), P.out, ssq_o};
        pg8::gemm_phase<EpiDown, pg8::StaticOrder, false>(ldsg, g, so, E, nullptr);
    }
    SEAM(8);
    if (IN(9)) {
        const int lane = tid & 63, wid = tid >> 6;
        for (int row = c * 8 + wid; row < S_; row += G * 8) { const float r = rstd_of(ssq_o[row], 1.0f / 2048.0f); f32x4* op = (f32x4*)(P.out + (size_t)row * DM);
#pragma unroll
            for (int i = 0; i < 8; ++i) { const f32x4 g = ((const f32x4*)P.final_norm)[lane + 64 * i]; op[lane + 64 * i] = op[lane + 64 * i] * r * g; } }
    }
#undef IN
#undef SEAM
}

#ifndef MK_FUSED
#define MK_FUSED 0
#endif
extern "C" void kernel_launch(void* const* d_in, const int* in_sizes, int n_in, void* d_out, int out_size, void* d_ws, size_t ws_size, hipStream_t stream) {
    static int grid = 0;
    if (grid == 0) {
        int dev = 0, cus = 0, per_cu = 0;
        (void)hipGetDevice(&dev); (void)hipDeviceGetAttribute(&cus, hipDeviceAttributeMultiprocessorCount, dev);
        if (hipFuncSetAttribute((const void*)hybrid_fwd, hipFuncAttributeMaxDynamicSharedMemorySize, LDS_BYTES) != hipSuccess) fprintf(stderr, "hipFuncSetAttribute failed\n");
        if (hipOccupancyMaxActiveBlocksPerMultiprocessor(&per_cu, (const void*)hybrid_fwd, 512, LDS_BYTES) != hipSuccess || per_cu < 1) { fprintf(stderr, "occupancy query: %d\n", per_cu); per_cu = 1; }
        (void)hipGetLastError();
        if (cus <= 0) cus = 256;
        grid = cus * (per_cu > 1 ? 1 : per_cu);
        if (ws_size < WS_END) fprintf(stderr, "kernel_launch: workspace %zu < %zu\n", ws_size, (size_t)WS_END);
    }
    (void)hipMemsetAsync((char*)d_ws + WS_BAR, 0, 256, stream);
    Params p{};
    p.x = (const float*)d_in[0]; p.pos = (const int*)d_in[1]; p.attn_norm = (const float*)d_in[2]; p.w_in = (const float*)d_in[3]; p.q_norm = (const float*)d_in[4];
    p.w_uq = (const float*)d_in[5]; p.kv_norm = (const float*)d_in[6]; p.w_ukv = (const float*)d_in[7]; p.w_ba = (const float*)d_in[8]; p.w_bb = (const float*)d_in[9];
    p.w_out = (const float*)d_in[10]; p.ffn_norm = (const float*)d_in[11]; p.w_gate = (const float*)d_in[12]; p.w_up = (const float*)d_in[13]; p.w_down = (const float*)d_in[14];
    p.final_norm = (const float*)d_in[15]; p.out = (float*)d_out; p.ws = (unsigned char*)d_ws;
    for (int i = 0; i < 16; ++i) p.invf_a[i] = (float)std::pow(500000.0, -(double)(2 * i) / 32.0);
    for (int i = 0; i < 32; ++i) p.invf_b[i] = (float)std::pow(500000.0, -(double)(2 * i) / 64.0);
#if MK_FUSED
    p.ph_lo = 0; p.ph_hi = 10;
    void* args[] = {&p};
    hipError_t e = hipLaunchCooperativeKernel((const void*)hybrid_fwd, dim3(grid), dim3(512), args, LDS_BYTES, stream);
    if (e != hipSuccess) fprintf(stderr, "cooperative launch failed: %s (grid %d)\n", hipGetErrorString(e), grid);
#else
    for (int ph = 0; ph < 10; ++ph) { p.ph_lo = ph; p.ph_hi = ph + 1; hipLaunchKernelGGL(hybrid_fwd, dim3(grid), dim3(512), LDS_BYTES, stream, p); }

#endif
}
```

```cpp
#define MK_FUSED 1
#include <hip/hip_runtime.h>
#include <hip/hip_cooperative_groups.h>
#include <cstdio>
#include <cstdint>
#include <cmath>
namespace cg = cooperative_groups;
namespace pg8 {
#define PG8_LAS __attribute__((address_space(3)))
typedef unsigned short bf16_t;
typedef short bf16x8 __attribute__((ext_vector_type(8)));
typedef float f32x4 __attribute__((ext_vector_type(4)));
typedef unsigned u32x4 __attribute__((ext_vector_type(4)));
constexpr int BM = 256, BK = 64, HALF = 128, HTB = HALF * BK * 2  , STAGE_BYTES = 8 * HTB, NXCD = 8, WGM = 8;

__host__ __device__ __forceinline__ int lds_byte(int r, int c) { const int st = (r >> 4) * 2 + (c >> 5), rr = r & 15, cc = c & 31, ob = rr * 64 + cc * 2; return st * 1024 + (ob ^ (((ob >> 9) & 1) << 5)); }
__host__ __device__ __forceinline__ void stage_rc(int b, int& R, int& C) { const int st = b / 1024, sb = b % 1024, swz = sb ^ (((sb >> 9) & 1) << 5); R = (st >> 1) * 16 + swz / 64; C = (st & 1) * 32 + (swz % 64) / 2; }
__host__ __device__ __forceinline__ int perm32(int rho) { const int n = rho >> 4, i = rho & 15; return 8 * (i >> 2) + 4 * n + (i & 3); }

struct Unit { int pm, pn; };
struct Gemm { const bf16_t* A; const bf16_t* Bt; int M, N, K; };

struct StaticOrder {
    int nM, nN, nwg, G, c;
    __host__ __device__ void init(int M, int N, int G_, int c_) { nM = M / BM; nN = N / BM; nwg = nM * nN; G = G_; c = c_; }
    __host__ __device__ bool next(int i, Unit& u) const {
        const long L = (long)i * G + c; if (L >= nwg) return false;
        int wgid = (int)L; { const int q = nwg / NXCD, r = nwg % NXCD, xcd = wgid % NXCD, off = wgid / NXCD; wgid = (xcd < r ? xcd * (q + 1) : r * (q + 1) + (xcd - r) * q) + off; }
        const int nig = WGM * nN, gid = wgid / nig, fm = gid * WGM, gsz = (nM - fm) < WGM ? (nM - fm) : WGM;
        u.pm = fm + ((wgid % nig) % gsz); u.pn = (wgid % nig) / gsz; return true;
    }
    __device__ __forceinline__ void a_ready(const Unit&) const {}
    __device__ __forceinline__ void done(const Unit&) const {}
};
typedef __bf16 bf16x2_n __attribute__((ext_vector_type(2)));
__device__ __forceinline__ unsigned cvt_pk_bf16(float lo, float hi) { bf16x2_n v = {(__bf16)lo, (__bf16)hi}; return __builtin_bit_cast(unsigned, v); }
typedef float f32x2 __attribute__((ext_vector_type(2)));
template <class Epi, class Sched, bool STAMP = false>
__device__ __forceinline__ void gemm_phase(PG8_LAS unsigned char* lds, const Gemm g, const Sched& S, const Epi& E, unsigned long long* stamps) {
    const int tid = threadIdx.x, wid = __builtin_amdgcn_readfirstlane(tid >> 6), lane = tid & 63, wr = wid >> 2, wc = wid & 3, fr = lane & 15, fq = lane >> 4;
    const int K = g.K, nt = K / BK;
    int ts_lo = 0, ts_hi = 0, nts = 0; const unsigned long long rt_entry = STAMP ? (unsigned long long)wall_clock64() : 0ull;
#define PG8_STAMP() do { if (STAMP && wid == 0 && nts < 64) { const unsigned long long _c = (unsigned long long)clock64(); \
        ts_lo = (lane == nts) ? (int)(unsigned)_c : ts_lo; ts_hi = (lane == nts) ? (int)(unsigned)(_c >> 32) : ts_hi; ++nts; } } while (0)
    PG8_STAMP();
    unsigned voffA[2], voffB[2];
#pragma unroll
    for (int i = 0; i < 2; ++i) { int R, C; stage_rc(tid * 16 + i * 8192, R, C); const int Rb = Epi::PERM ? ((R & ~31) + perm32(R & 31)) : R;
        voffA[i] = (unsigned)(R * K + C) * 2u; voffB[i] = (unsigned)(Rb * K + C) * 2u; }
    const size_t kstep = (size_t)(BK * 2);
    const size_t hstep = (size_t)HALF * K * 2;
    const size_t tstep = 2 * hstep;
    const unsigned ldsw = (unsigned)wid * 1024u;
    const int aoff = lds_byte(wr * 64 + fr, fq * 8), boff = lds_byte(wc * 32 + fr, fq * 8);
#define PG8_SA(b, h) (((b) * 2 + (h)) * HTB)
#define PG8_SB(b, h) ((4 + (b) * 2 + (h)) * HTB)
#define PG8_STAGE(bufoff, gbase, voff) do { _Pragma("unroll") for (int _i = 0; _i < 2; ++_i) \
        __builtin_amdgcn_global_load_lds((const unsigned*)((const char*)(gbase) + (voff)[_i]), (PG8_LAS unsigned*)(lds + (bufoff) + ldsw + _i * 8192), 16, 0, 0); } while (0)
#define PG8_LDA(dst, b, h) do { _Pragma("unroll") for (int m = 0; m < 4; ++m) _Pragma("unroll") for (int k = 0; k < 2; ++k) dst[m][k] = *(const PG8_LAS bf16x8*)(lds + PG8_SA(b, h) + aoff + m * 2048 + k * 1024); } while (0)
#define PG8_LDB(dst, b, h) do { _Pragma("unroll") for (int n = 0; n < 2; ++n) _Pragma("unroll") for (int k = 0; k < 2; ++k) dst[n][k] = *(const PG8_LAS bf16x8*)(lds + PG8_SB(b, h) + boff + n * 2048 + k * 1024); } while (0)
#define PG8_MMA(ai, bj, At, Bt) do { __builtin_amdgcn_s_setprio(1); _Pragma("unroll") for (int m = 0; m < 4; ++m) _Pragma("unroll") for (int n = 0; n < 2; ++n) _Pragma("unroll") for (int k = 0; k < 2; ++k) \
        acc[ai][bj][m][n] = __builtin_amdgcn_mfma_f32_16x16x32_bf16(Bt[n][k], At[m][k], acc[ai][bj][m][n], 0, 0, 0); __builtin_amdgcn_s_setprio(0); } while (0)
#define PG8_WAIT_V(n) asm volatile("s_waitcnt vmcnt(" #n ")" ::: "memory")
#define PG8_WAIT_L(n) asm volatile("s_waitcnt lgkmcnt(" #n ")" ::: "memory")
#define PG8_BAR __builtin_amdgcn_s_barrier()
#define PG8_SCHED __builtin_amdgcn_sched_barrier(0)
    Unit cur, nxt; int ui = 0;
    if (!S.next(0, cur)) return;
    f32x4 acc[2][2][4][2];
#pragma unroll
    for (int a = 0; a < 2; ++a)
#pragma unroll
        for (int b = 0; b < 2; ++b)
#pragma unroll
            for (int m = 0; m < 4; ++m)
#pragma unroll
                for (int n = 0; n < 2; ++n) acc[a][b][m][n] = (f32x4){0.f, 0.f, 0.f, 0.f};
    bf16x8 At[4][2], B0[2][2], B1[2][2];
    const char* cA = (const char*)g.A + (size_t)cur.pm * tstep; const char* cB = (const char*)g.Bt + (size_t)cur.pn * tstep;
    S.a_ready(cur);
    PG8_STAGE(PG8_SB(0, 0), cB, voffB); PG8_STAGE(PG8_SA(0, 0), cA, voffA); PG8_STAGE(PG8_SB(0, 1), cB + hstep, voffB); PG8_STAGE(PG8_SA(0, 1), cA + hstep, voffA);
    if (wr == 1) PG8_BAR;
    PG8_WAIT_V(4); PG8_BAR;
    PG8_STAGE(PG8_SB(1, 0), cB + kstep, voffB); PG8_STAGE(PG8_SA(1, 0), cA + kstep, voffA); PG8_STAGE(PG8_SB(1, 1), cB + hstep + kstep, voffB);
    PG8_WAIT_V(6); PG8_BAR;
    PG8_STAMP();
    for (;;) {
        const bool has_next = S.next(ui + 1, nxt);
        const char* nA = has_next ? (const char*)g.A + (size_t)nxt.pm * tstep : cA; const char* nB = has_next ? (const char*)g.Bt + (size_t)nxt.pn * tstep : cB;
        for (int t = 0; t < nt; t += 2) {
            const bool last = (t == nt - 2);
            const char* a1 = cA + (size_t)(t + 1) * kstep;
            const char* a2 = last ? nA : cA + (size_t)(t + 2) * kstep; const char* b2 = last ? nB : cB + (size_t)(t + 2) * kstep;
            const char* a3 = a2 + kstep; const char* b3 = b2 + kstep;
            if (last && has_next) S.a_ready(nxt);
            PG8_LDB(B0, 0, 0); PG8_SCHED; PG8_LDA(At, 0, 0); PG8_STAGE(PG8_SA(1, 1), a1 + hstep, voffA);
            PG8_WAIT_L(8); PG8_BAR; PG8_WAIT_L(0); PG8_MMA(0, 0, At, B0); PG8_BAR; PG8_SCHED;
            PG8_LDB(B1, 0, 1); PG8_STAGE(PG8_SB(0, 0), b2, voffB);
            PG8_BAR; PG8_WAIT_L(0); PG8_MMA(0, 1, At, B1); PG8_BAR;
            PG8_LDA(At, 0, 1); PG8_STAGE(PG8_SA(0, 0), a2, voffA);
            PG8_BAR; PG8_WAIT_L(0); PG8_MMA(1, 0, At, B0); PG8_BAR; PG8_SCHED;
            PG8_STAGE(PG8_SB(0, 1), b2 + hstep, voffB);
            PG8_WAIT_V(6); PG8_BAR; PG8_MMA(1, 1, At, B1); PG8_BAR;
            PG8_LDB(B0, 1, 0); PG8_SCHED; PG8_LDA(At, 1, 0); PG8_STAGE(PG8_SA(0, 1), a2 + hstep, voffA);
            PG8_WAIT_L(8); PG8_BAR; PG8_WAIT_L(0); PG8_MMA(0, 0, At, B0); PG8_BAR; PG8_SCHED;
            PG8_LDB(B1, 1, 1); PG8_STAGE(PG8_SB(1, 0), b3, voffB);
            PG8_BAR; PG8_WAIT_L(0); PG8_MMA(0, 1, At, B1); PG8_BAR;
            PG8_LDA(At, 1, 1); PG8_STAGE(PG8_SA(1, 0), a3, voffA);
            PG8_BAR; PG8_WAIT_L(0); PG8_MMA(1, 0, At, B0); PG8_BAR; PG8_SCHED;
            PG8_STAGE(PG8_SB(1, 1), b3 + hstep, voffB);
            PG8_WAIT_V(6); PG8_BAR; PG8_MMA(1, 1, At, B1); PG8_BAR;
        }
        PG8_STAMP();
        if constexpr (!Epi::AFTER_DRAIN) { E(acc, cur, wr, wc, fr, fq); S.done(cur); }
        PG8_STAMP();
        if (!has_next) break;
#pragma unroll
        for (int a = 0; a < 2; ++a)
#pragma unroll
            for (int b = 0; b < 2; ++b)
#pragma unroll
                for (int m = 0; m < 4; ++m)
#pragma unroll
                    for (int n = 0; n < 2; ++n) acc[a][b][m][n] = (f32x4){0.f, 0.f, 0.f, 0.f};
        cur = nxt; cA = nA; cB = nB; ++ui;
    }
    PG8_WAIT_V(0);
    if (wr == 0) PG8_BAR;
    PG8_BAR;
    if constexpr (Epi::AFTER_DRAIN) { E.fused(acc, cur, wr, wc, fr, fq, lds, wid, lane); S.done(cur); }
    PG8_STAMP();
    if (STAMP && wid == 0) { stamps[lane] = lane < nts ? (((unsigned long long)(unsigned)ts_hi << 32) | (unsigned)ts_lo) : 0ull;
        if (lane == 62) stamps[62] = rt_entry; if (lane == 63) stamps[63] = (unsigned long long)wall_clock64(); }
#undef PG8_STAMP
#undef PG8_SA
#undef PG8_SB
#undef PG8_STAGE
#undef PG8_LDA
#undef PG8_LDB
#undef PG8_MMA
#undef PG8_WAIT_V
#undef PG8_WAIT_L
#undef PG8_BAR
#undef PG8_SCHED
}
}

using pg8::bf16_t; using pg8::bf16x8; using pg8::f32x4; using pg8::u32x4; using pg8::Unit; using pg8::cvt_pk_bf16;
typedef short s16x4 __attribute__((ext_vector_type(4)));
typedef float f32x16 __attribute__((ext_vector_type(16)));
typedef unsigned long long u64;
constexpr int S_ = 16384, DM = 2048, DFF = 5632;
constexpr float EPS_ = 1e-6f;
constexpr size_t MiB = (size_t)1 << 20;
constexpr size_t WS_WIN = 0, WS_WUQ = 32 * MiB, WS_WUKV = WS_WUQ + 3 * MiB / 2, WS_WBR = WS_WUKV + MiB, WS_WOUT = WS_WBR + 8 * MiB, WS_WGU = WS_WOUT + 8 * MiB,
                 WS_WDN = WS_WGU + 44 * MiB, WS_CSA = WS_WDN + 22 * MiB, WS_CSB = WS_CSA + 2 * MiB, WS_SEL = WS_CSB + 4 * MiB, WS_KMS = WS_SEL + MiB,
                 WS_SSQ = WS_KMS + MiB / 4, WS_CTL = WS_SSQ + MiB / 4, WS_BAR = WS_CTL + 65536, WS_ACT = 128 * MiB, WS_END = 512 * MiB;
static_assert(WS_BAR + 4096 <= WS_ACT, "ws map");
constexpr size_t A_XN = 0, A_QA = 64 * MiB, A_KA = 96 * MiB, A_VA = 128 * MiB, A_CQ = 160 * MiB, A_CKV = 176 * MiB, A_KRP = 184 * MiB,
                 A_QN = 0, A_KN = 32 * MiB, A_VB = 192 * MiB, A_QRP = 224 * MiB, A_Y = 240 * MiB, A_T = 0, A_MIX = 128 * MiB,
                 A_HF = 256 * MiB, A_HB = 0, A_ACTV = 64 * MiB,
                 A_P0 = 304 * MiB, A_P1 = 336 * MiB, A_ML = 368 * MiB, A_LIST = 372 * MiB;

struct Params {
    const float* x; const int* pos; const float* attn_norm; const float* w_in; const float* q_norm; const float* w_uq; const float* kv_norm; const float* w_ukv;
    const float* w_ba; const float* w_bb; const float* w_out; const float* ffn_norm; const float* w_gate; const float* w_up; const float* w_down; const float* final_norm;
    float* out; unsigned char* ws;
    float invf_a[16]; float invf_b[32];
    int ph_lo, ph_hi;
};

__device__ __forceinline__ float bflo(unsigned u) { return __uint_as_float(u << 16); }
__device__ __forceinline__ float bfhi(unsigned u) { return __uint_as_float(u & 0xffff0000u); }
__device__ __forceinline__ void st8(bf16_t* p, f32x4 a, f32x4 b) {
    u32x4 w; w.x = cvt_pk_bf16(a[0], a[1]); w.y = cvt_pk_bf16(a[2], a[3]); w.z = cvt_pk_bf16(b[0], b[1]); w.w = cvt_pk_bf16(b[2], b[3]); *(u32x4*)p = w; }
__device__ __forceinline__ void rot4(f32x4& v, const f32x4 t) {
    const float a0 = v[0] * t[0] - v[1] * t[1], a1 = v[1] * t[0] + v[0] * t[1], b0 = v[2] * t[2] - v[3] * t[3], b1 = v[3] * t[2] + v[2] * t[3];
    v[0] = a0; v[1] = a1; v[2] = b0; v[3] = b1; }
__device__ __forceinline__ float sigm(float x) { return __builtin_amdgcn_rcpf(1.0f + __builtin_amdgcn_exp2f(x * -1.4426950408889634f)); }
__device__ __forceinline__ float sq4(const f32x4 v) { return (v[0] * v[0] + v[1] * v[1]) + (v[2] * v[2] + v[3] * v[3]); }
__device__ __forceinline__ float rstd_of(float ssq, float inv_n) { return __builtin_amdgcn_rsqf(ssq * inv_n + EPS_); }

struct EpiProj {
    static constexpr bool PERM = true, AFTER_DRAIN = false;
    bf16_t *qa, *ka, *va, *cq, *ckv, *krp, *gates; const float* csa; const float* csb; float *kms, *ssq_q, *ssq_kv;
    __device__ __forceinline__ void operator()(const f32x4 (&acc)[2][2][4][2], const Unit& u, int wr, int wc, int fr, int fq) const {
        const int pn = u.pn, row0 = u.pm * 256 + wr * 64 + fr, cl = wc * 32 + 8 * fq;
        if (pn < 8) {
            bf16_t* dst = pn < 4 ? qa : ka; const bool isk = pn >= 4; const int hb = (pn & 3) * 256;
            float ks[2][8];
#pragma unroll
            for (int b = 0; b < 2; ++b)
#pragma unroll
                for (int i = 0; i < 8; ++i) ks[b][i] = 0.f;
#pragma unroll
            for (int ai = 0; ai < 2; ++ai)
#pragma unroll
            for (int mh = 0; mh < 2; ++mh) {
                f32x4 tt0[4], tt1[4];
#pragma unroll
                for (int m = 2 * mh; m < 2 * mh + 2; ++m) { tt0[m] = (f32x4){1.f, 0.f, 1.f, 0.f}; tt1[m] = tt0[m];
                    if (wc == 0) { const f32x4* tp = (const f32x4*)(csa + (size_t)(row0 + ai * 128 + m * 16) * 32 + 8 * fq); tt0[m] = tp[0]; tt1[m] = tp[1]; } }
#pragma unroll
                for (int m = 2 * mh; m < 2 * mh + 2; ++m) { const int row = row0 + ai * 128 + m * 16; const f32x4 t0 = tt0[m], t1 = tt1[m];
#pragma unroll
                    for (int bj = 0; bj < 2; ++bj) { f32x4 v0 = acc[ai][bj][m][0], v1 = acc[ai][bj][m][1];
                        if (wc == 0) { rot4(v0, t0); rot4(v1, t1); }
                        if (isk) {
#pragma unroll
                            for (int i = 0; i < 4; ++i) { ks[bj][i] += v0[i]; ks[bj][4 + i] += v1[i]; } }
                        st8(dst + (size_t)row * 1024 + hb + bj * 128 + cl, v0, v1); } } }
            if (isk) {
#pragma unroll
                for (int bj = 0; bj < 2; ++bj)
#pragma unroll
                    for (int i = 0; i < 8; ++i) { float s = ks[bj][i]; s += __shfl_xor(s, 1); s += __shfl_xor(s, 2); s += __shfl_xor(s, 4); s += __shfl_xor(s, 8);
                        if (fr == 0) atomicAdd(kms + ((size_t)((pn & 3) * 2 + bj) * 64 + u.pm) * 128 + cl + i, s); } }
        } else if (pn < 12) {
#pragma unroll
            for (int ai = 0; ai < 2; ++ai)
#pragma unroll
                for (int m = 0; m < 4; ++m) { const int row = row0 + ai * 128 + m * 16;
#pragma unroll
                    for (int bj = 0; bj < 2; ++bj) st8(va + (size_t)row * 1024 + (pn - 8) * 256 + bj * 128 + cl, acc[ai][bj][m][0], acc[ai][bj][m][1]); }
        } else if (pn < 15) {
            const bool isq = pn < 14; bf16_t* dst = isq ? cq : ckv; const int ld = isq ? 512 : 256, cb = isq ? (pn - 12) * 256 : 0; float* ssq = isq ? ssq_q : ssq_kv;
#pragma unroll
            for (int ai = 0; ai < 2; ++ai)
#pragma unroll
                for (int m = 0; m < 4; ++m) { const int row = row0 + ai * 128 + m * 16; float s = 0.f;
#pragma unroll
                    for (int bj = 0; bj < 2; ++bj) { s += sq4(acc[ai][bj][m][0]) + sq4(acc[ai][bj][m][1]); st8(dst + (size_t)row * ld + cb + bj * 128 + cl, acc[ai][bj][m][0], acc[ai][bj][m][1]); }
                    s += __shfl_xor(s, 16); s += __shfl_xor(s, 32);
                    if (fq == 0) atomicAdd(ssq + row, s); }
        } else if (pn == 15) {
            if (wc < 2) {
#pragma unroll
                for (int ai = 0; ai < 2; ++ai)
#pragma unroll
                for (int mh = 0; mh < 2; ++mh) { f32x4 tt0[4], tt1[4];
#pragma unroll
                    for (int m = 2 * mh; m < 2 * mh + 2; ++m) { const f32x4* tp = (const f32x4*)(csb + (size_t)(row0 + ai * 128 + m * 16) * 64 + 32 * wc + 8 * fq); tt0[m] = tp[0]; tt1[m] = tp[1]; }
#pragma unroll
                    for (int m = 2 * mh; m < 2 * mh + 2; ++m) { const int row = row0 + ai * 128 + m * 16; f32x4 v0 = acc[ai][0][m][0], v1 = acc[ai][0][m][1];
                        rot4(v0, tt0[m]); rot4(v1, tt1[m]); st8(krp + (size_t)row * 64 + cl, v0, v1); } } }
        } else {
#pragma unroll
            for (int ai = 0; ai < 2; ++ai)
#pragma unroll
                for (int m = 0; m < 4; ++m) { const int row = row0 + ai * 128 + m * 16;
#pragma unroll
                    for (int bj = 0; bj < 2; ++bj) { f32x4 v0 = acc[ai][bj][m][0], v1 = acc[ai][bj][m][1];
#pragma unroll
                        for (int i = 0; i < 4; ++i) { v0[i] = sigm(v0[i]); v1[i] = sigm(v1[i]); }
                        st8(gates + (size_t)row * 4096 + (pn - 16) * 256 + bj * 128 + cl, v0, v1); } }
        }
    }
};
struct EpiQ {
    static constexpr bool PERM = true, AFTER_DRAIN = false;
    bf16_t *qn, *qrp; const float* csb; const float* ssq_q;
    __device__ __forceinline__ void operator()(const f32x4 (&acc)[2][2][4][2], const Unit& u, int wr, int wc, int fr, int fq) const {
        const int pn = u.pn, row0 = u.pm * 256 + wr * 64 + fr, cl = wc * 32 + 8 * fq;
        float sq[2][4];
#pragma unroll
        for (int ai = 0; ai < 2; ++ai)
#pragma unroll
            for (int m = 0; m < 4; ++m) sq[ai][m] = ssq_q[row0 + ai * 128 + m * 16];
#pragma unroll
        for (int ai = 0; ai < 2; ++ai)
#pragma unroll
        for (int mh = 0; mh < 2; ++mh) { f32x4 tt0[4], tt1[4];
#pragma unroll
            for (int m = 2 * mh; m < 2 * mh + 2; ++m) if (pn >= 4) { const f32x4* tp = (const f32x4*)(csb + (size_t)(row0 + ai * 128 + m * 16) * 64 + 32 * (wc & 1) + 8 * fq); tt0[m] = tp[0]; tt1[m] = tp[1]; }
#pragma unroll
            for (int m = 2 * mh; m < 2 * mh + 2; ++m) { const int row = row0 + ai * 128 + m * 16; const float r = rstd_of(sq[ai][m], 1.0f / 512.0f);
                if (pn < 4) {
#pragma unroll
                    for (int bj = 0; bj < 2; ++bj) st8(qn + (size_t)row * 1024 + pn * 256 + bj * 128 + cl, acc[ai][bj][m][0] * r, acc[ai][bj][m][1] * r);
                } else { const f32x4 t0 = tt0[m], t1 = tt1[m];
#pragma unroll
                    for (int bj = 0; bj < 2; ++bj) { f32x4 v0 = acc[ai][bj][m][0] * r, v1 = acc[ai][bj][m][1] * r; rot4(v0, t0); rot4(v1, t1);
                        st8(qrp + (size_t)row * 512 + (pn - 4) * 256 + bj * 128 + cl, v0, v1); } } } }
    }
};
struct EpiKV {
    static constexpr bool PERM = true, AFTER_DRAIN = false;
    bf16_t *kn, *vb; const float* ssq_kv;
    __device__ __forceinline__ void operator()(const f32x4 (&acc)[2][2][4][2], const Unit& u, int wr, int wc, int fr, int fq) const {
        const int pn = u.pn, row0 = u.pm * 256 + wr * 64 + fr, cl = wc * 32 + 8 * fq;
        float sq[2][4];
#pragma unroll
        for (int ai = 0; ai < 2; ++ai)
#pragma unroll
            for (int m = 0; m < 4; ++m) sq[ai][m] = ssq_kv[row0 + ai * 128 + m * 16];
#pragma unroll
        for (int ai = 0; ai < 2; ++ai)
#pragma unroll
            for (int m = 0; m < 4; ++m) { const int row = row0 + ai * 128 + m * 16; const float r = rstd_of(sq[ai][m], 1.0f / 256.0f);
                st8(kn + (size_t)row * 1024 + pn * 128 + cl, acc[ai][0][m][0] * r, acc[ai][0][m][1] * r);
                st8(vb + (size_t)row * 1024 + pn * 128 + cl, acc[ai][1][m][0] * r, acc[ai][1][m][1] * r);
                asm volatile("" ::: "memory"); }
    }
};
struct EpiBranch {
    static constexpr bool PERM = true, AFTER_DRAIN = false;
    const bf16_t* gates; bf16_t* T; bf16_t* mixed;
    __device__ __forceinline__ void operator()(const f32x4 (&acc)[2][2][4][2], const Unit& u, int wr, int wc, int fr, int fq) const {
        const bool isb = u.pm >= 64; const int pm = isb ? u.pm - 64 : u.pm, pn = isb ? u.pn - 8 : u.pn;
        const int row0 = pm * 256 + wr * 64 + fr, cl = wc * 32 + 8 * fq;
#pragma unroll
        for (int ai = 0; ai < 2; ++ai) {
            u32x4 gwv[4][2], tvv[4][2];
#pragma unroll
            for (int m = 0; m < 4; ++m)
#pragma unroll
                for (int bj = 0; bj < 2; ++bj) { const int row = row0 + ai * 128 + m * 16, col = pn * 256 + bj * 128 + cl;
                    gwv[m][bj] = *(const u32x4*)(gates + (size_t)row * 4096 + (isb ? 2048 : 0) + col);
                    if (isb) tvv[m][bj] = *(const u32x4*)(T + (size_t)row * 2048 + col); }
#pragma unroll
            for (int m = 0; m < 4; ++m) { const int row = row0 + ai * 128 + m * 16;
#pragma unroll
                for (int bj = 0; bj < 2; ++bj) { const int col = pn * 256 + bj * 128 + cl;
                    const u32x4 gw = gwv[m][bj];
                    const f32x4 g0 = {bflo(gw.x), bfhi(gw.x), bflo(gw.y), bfhi(gw.y)}, g1 = {bflo(gw.z), bfhi(gw.z), bflo(gw.w), bfhi(gw.w)};
                    if (!isb) st8(T + (size_t)row * 2048 + col, g0 * acc[ai][bj][m][0], g1 * acc[ai][bj][m][1]);
                    else { const u32x4 tw = tvv[m][bj];
                        const f32x4 a0 = {bflo(tw.x), bfhi(tw.x), bflo(tw.y), bfhi(tw.y)}, a1 = {bflo(tw.z), bfhi(tw.z), bflo(tw.w), bfhi(tw.w)};
                        st8(mixed + (size_t)row * 2048 + col, a0 + g0 * acc[ai][bj][m][0], a1 + g1 * acc[ai][bj][m][1]); } } } }
    }
};
struct BranchOrder {
    pg8::StaticOrder so;
    __device__ void init(int G, int c) { so.init(S_, DM, G, c); }
    __device__ bool next(int i, Unit& u) const { if (!so.next(i >> 1, u)) return false; if (i & 1) { u.pm += 64; u.pn += 8; } return true; }
    __device__ __forceinline__ void a_ready(const Unit&) const {}
    __device__ __forceinline__ void done(const Unit&) const {}
};
struct EpiOut {
    static constexpr bool PERM = true, AFTER_DRAIN = false;
    const float* x; float* hf; bf16_t* hb; float* ssq_h;
    __device__ __forceinline__ void operator()(const f32x4 (&acc)[2][2][4][2], const Unit& u, int wr, int wc, int fr, int fq) const {
        const int pn = u.pn, row0 = u.pm * 256 + wr * 64 + fr, cl = wc * 32 + 8 * fq;
#pragma unroll
        for (int ai = 0; ai < 2; ++ai) {
            f32x4 xv0[4][2], xv1[4][2];
#pragma unroll
            for (int m = 0; m < 4; ++m)
#pragma unroll
                for (int bj = 0; bj < 2; ++bj) { const size_t o = (size_t)(row0 + ai * 128 + m * 16) * 2048 + pn * 256 + bj * 128 + cl; xv0[m][bj] = *(const f32x4*)(x + o); xv1[m][bj] = *(const f32x4*)(x + o + 4); }
#pragma unroll
            for (int m = 0; m < 4; ++m) { const int row = row0 + ai * 128 + m * 16; float s = 0.f;
#pragma unroll
                for (int bj = 0; bj < 2; ++bj) { const size_t o = (size_t)row * 2048 + pn * 256 + bj * 128 + cl;
                    const f32x4 h0 = xv0[m][bj] + acc[ai][bj][m][0], h1 = xv1[m][bj] + acc[ai][bj][m][1];
                    *(f32x4*)(hf + o) = h0; *(f32x4*)(hf + o + 4) = h1; st8(hb + o, h0, h1); s += sq4(h0) + sq4(h1); }
                s += __shfl_xor(s, 16); s += __shfl_xor(s, 32);
                if (fq == 0) atomicAdd(ssq_h + row, s); } }
    }
};
struct EpiGU {
    static constexpr bool PERM = true, AFTER_DRAIN = false;
    bf16_t* act; const float* ssq_h;
    __device__ __forceinline__ void operator()(const f32x4 (&acc)[2][2][4][2], const Unit& u, int wr, int wc, int fr, int fq) const {
        const int pn = u.pn, row0 = u.pm * 256 + wr * 64 + fr, cl = wc * 32 + 8 * fq;
        float sq[2][4];
#pragma unroll
        for (int ai = 0; ai < 2; ++ai)
#pragma unroll
            for (int m = 0; m < 4; ++m) sq[ai][m] = ssq_h[row0 + ai * 128 + m * 16];
#pragma unroll
        for (int ai = 0; ai < 2; ++ai)
#pragma unroll
            for (int m = 0; m < 4; ++m) { const int row = row0 + ai * 128 + m * 16; const float r = rstd_of(sq[ai][m], 1.0f / 2048.0f);
                f32x4 o0, o1;
#pragma unroll
                for (int i = 0; i < 4; ++i) { const float g0 = acc[ai][0][m][0][i] * r, g1 = acc[ai][0][m][1][i] * r;
                    o0[i] = g0 * sigm(g0) * (acc[ai][1][m][0][i] * r); o1[i] = g1 * sigm(g1) * (acc[ai][1][m][1][i] * r); }
                st8(act + (size_t)row * DFF + pn * 128 + cl, o0, o1); }
    }
};
struct EpiDown {
    static constexpr bool PERM = true, AFTER_DRAIN = false;
    const float* hf; float* out; float* ssq_o;
    __device__ __forceinline__ void operator()(const f32x4 (&acc)[2][2][4][2], const Unit& u, int wr, int wc, int fr, int fq) const {
        const int pn = u.pn, row0 = u.pm * 256 + wr * 64 + fr, cl = wc * 32 + 8 * fq;
#pragma unroll
        for (int ai = 0; ai < 2; ++ai) {
            f32x4 xv0[4][2], xv1[4][2];
#pragma unroll
            for (int m = 0; m < 4; ++m)
#pragma unroll
                for (int bj = 0; bj < 2; ++bj) { const size_t o = (size_t)(row0 + ai * 128 + m * 16) * 2048 + pn * 256 + bj * 128 + cl; xv0[m][bj] = *(const f32x4*)(hf + o); xv1[m][bj] = *(const f32x4*)(hf + o + 4); }
#pragma unroll
            for (int m = 0; m < 4; ++m) { const int row = row0 + ai * 128 + m * 16; float s = 0.f;
#pragma unroll
                for (int bj = 0; bj < 2; ++bj) { const size_t o = (size_t)row * 2048 + pn * 256 + bj * 128 + cl;
                    const f32x4 h0 = xv0[m][bj] + acc[ai][bj][m][0], h1 = xv1[m][bj] + acc[ai][bj][m][1];
                    *(f32x4*)(out + o) = h0; *(f32x4*)(out + o + 4) = h1; s += sq4(h0) + sq4(h1); }
                s += __shfl_xor(s, 16); s += __shfl_xor(s, 32);
                if (fq == 0) atomicAdd(ssq_o + row, s); } }
    }
};

namespace att {
constexpr int SHM_V = 16384, SHM_K = 16384, SHM_K2 = 64 * 144;
constexpr int OFF_K = 0, OFF_K2 = 2 * SHM_K, OFF_V = OFF_K2 + 2 * SHM_K2, OFF_WS = OFF_V + 2 * SHM_V, OFF_MISC = OFF_WS + 8 * 64 * 4, OFF_Q2 = OFF_MISC + 1024;
#define KSWZ(row, colB) ((row) * 256 + ((colB) ^ (((row) & 7) << 4)))
#define K2SWZ(row, colB) ((row) * 144 + (colB))
#define SBAR() __builtin_amdgcn_sched_barrier(0)
__device__ __forceinline__ int v_st(int k, int c) { const int kk = (k & ~0xC) | ((k & 4) << 1) | ((k & 8) >> 1); return ((kk >> 3) * 4 + (c >> 5)) * 512 + ((kk & 7) * 32 + (c & 31)) * 2; }
__device__ __forceinline__ int v_rd_base(int lane) { return ((lane & 3) << 3) | (((lane >> 2) & 3) << 6) | (((lane >> 4) & 1) << 5) | (((lane >> 5) & 1) << 8); }
constexpr int v_rd_off(int d0, int ks, int half) { return d0 * 512 + ks * 4096 + half * 2048; }
__device__ __forceinline__ int crow(int r, int hi) { return (r & 3) + 8 * (r >> 2) + 4 * hi; }
__device__ __forceinline__ unsigned cvtpk(float lo, float hi) { return pg8::cvt_pk_bf16(lo, hi); }
__device__ __forceinline__ void mask_tile(f32x16& p0, f32x16& p1, int dq) {
    const float NEG = -__builtin_inff();
#pragma unroll
    for (int r = 0; r < 16; ++r) { const int c = (r & 3) + 8 * (r >> 2);
        if (dq - c < 0) p0[r] = NEG;
        if (dq - c - 32 < 0) p1[r] = NEG; }
}
__device__ __forceinline__ void partialSM(f32x16& p0, f32x16& p1, float& m_reg, float& mn, float& alpha, const float C2) {
    float pmax = p0[0];
#pragma unroll
    for (int r = 1; r < 16; ++r) pmax = fmaxf(pmax, p0[r]);
#pragma unroll
    for (int r = 0; r < 16; ++r) pmax = fmaxf(pmax, p1[r]);
    { auto rr = __builtin_amdgcn_permlane32_swap(__float_as_uint(pmax), __float_as_uint(pmax), false, false);
      pmax = fmaxf(__uint_as_float(rr[0]), __uint_as_float(rr[1])); }
    if (__builtin_expect(__all((pmax - m_reg) * C2 <= 11.5f), 1)) { mn = m_reg; alpha = 1.f; }
    else { mn = fmaxf(m_reg, pmax); alpha = __builtin_amdgcn_exp2f((m_reg - mn) * C2); m_reg = mn; }
    const float mnL = -mn * C2;
#pragma unroll
    for (int r = 0; r < 16; ++r) p0[r] = fmaf(p0[r], C2, mnL);
#pragma unroll
    for (int r = 0; r < 16; ++r) p1[r] = fmaf(p1[r], C2, mnL);
#pragma unroll
    for (int r = 0; r < 16; ++r) p0[r] = __builtin_amdgcn_exp2f(p0[r]);
}
__device__ __forceinline__ void finishSM(f32x16& p0, f32x16& p1, float alpha, float& l_reg, bf16x8& pa0, bf16x8& pa1, bf16x8& pa2, bf16x8& pa3) {
#pragma unroll
    for (int r = 0; r < 16; ++r) p1[r] = __builtin_amdgcn_exp2f(p1[r]);
    float ps = 0;
#pragma unroll
    for (int r = 0; r < 16; ++r) ps += p0[r];
#pragma unroll
    for (int r = 0; r < 16; ++r) ps += p1[r];
    { auto rr = __builtin_amdgcn_permlane32_swap(__float_as_uint(ps), __float_as_uint(ps), false, false);
      ps = __uint_as_float(rr[0]) + __uint_as_float(rr[1]); }
    l_reg = l_reg * alpha + ps;
#define PK4(P, B_, OUT) do { unsigned a0 = cvtpk(P[B_+0], P[B_+1]), a1 = cvtpk(P[B_+2], P[B_+3]);                          \
        unsigned b0 = cvtpk(P[B_+4], P[B_+5]), b1 = cvtpk(P[B_+6], P[B_+7]);                                             \
        auto r0 = __builtin_amdgcn_permlane32_swap(a0, b0, false, false); auto r1 = __builtin_amdgcn_permlane32_swap(a1, b1, false, false); \
        u32x4 w = {r0[0], r1[0], r0[1], r1[1]}; OUT = *reinterpret_cast<bf16x8*>(&w); } while (0)
    PK4(p0, 0, pa0); PK4(p0, 8, pa1); PK4(p1, 0, pa2); PK4(p1, 8, pa3);
#undef PK4
}
__device__ __forceinline__ bf16x8 pack8v(const f32x16& p, int b) { u32x4 w = {cvtpk(p[b], p[b + 1]), cvtpk(p[b + 2], p[b + 3]), cvtpk(p[b + 4], p[b + 5]), cvtpk(p[b + 6], p[b + 7])}; return *reinterpret_cast<bf16x8*>(&w); }
template <int KB, bool MLA>
__device__ __forceinline__ void qkt(f32x16& p0, f32x16& p1, const char* lds, int r32, int hi, const bf16x8* qr, const char* q2p) {
    p0 = f32x16{}; p1 = f32x16{};
    const char* kb[4];
#pragma unroll
    for (int dd = 0; dd < 4; ++dd) kb[dd] = lds + OFF_K + KB * SHM_K + KSWZ(r32, (dd * 16 + hi * 8) * 2);
#pragma unroll
    for (int d0 = 0; d0 < 8; ++d0) { const char* a = kb[d0 & 3] + (d0 >> 2) * 128;
        bf16x8 b0 = *reinterpret_cast<const bf16x8*>(a);
        bf16x8 b1 = *reinterpret_cast<const bf16x8*>(a + 32 * 256);
        p0 = __builtin_amdgcn_mfma_f32_32x32x16_bf16(b0, qr[d0], p0, 0, 0, 0);
        p1 = __builtin_amdgcn_mfma_f32_32x32x16_bf16(b1, qr[d0], p1, 0, 0, 0); }
    if constexpr (MLA) {
#pragma unroll
        for (int d0 = 0; d0 < 4; ++d0) { const char* a = lds + OFF_K2 + KB * SHM_K2 + K2SWZ(r32, (d0 * 16 + hi * 8) * 2);
            bf16x8 b0 = *reinterpret_cast<const bf16x8*>(a);
            bf16x8 b1 = *reinterpret_cast<const bf16x8*>(a + 32 * 144);
            const bf16x8 qf = *reinterpret_cast<const bf16x8*>(q2p + d0 * 1024);
            p0 = __builtin_amdgcn_mfma_f32_32x32x16_bf16(b0, qf, p0, 0, 0, 0);
            p1 = __builtin_amdgcn_mfma_f32_32x32x16_bf16(b1, qf, p1, 0, 0, 0); }
    }
    constexpr int NR = MLA ? 28 : 16, NM = MLA ? 24 : 16, AHEAD = 8;
    __builtin_amdgcn_sched_group_barrier(0x100, AHEAD, 0);
#pragma unroll
    for (int i = 0; i < NR - AHEAD; ++i) { __builtin_amdgcn_sched_group_barrier(0x008, 1, 0); __builtin_amdgcn_sched_group_barrier(0x100, 1, 0); }
    __builtin_amdgcn_sched_group_barrier(0x008, NM - (NR - AHEAD), 0);
}
typedef s16x4 __attribute__((address_space(3)))* lds_s16x4_p;
template <int VB>
__device__ __forceinline__ void pv_tile(f32x16* o, const __attribute__((address_space(3))) char* vbp, bf16x8 pa0, bf16x8 pa1, bf16x8 pa2, bf16x8 pa3) {
#define TRRD(off) __builtin_amdgcn_ds_read_tr16_b64_v4i16((lds_s16x4_p)(vbp + (off)))
#define PV_D0(d0) do { constexpr int b_ = VB * SHM_V + v_rd_off(d0, 0, 0);                                                                   \
        const s16x4 l0 = TRRD(b_), h0 = TRRD(b_ + 2048), l1 = TRRD(b_ + 4096), h1 = TRRD(b_ + 6144), l2 = TRRD(b_ + 8192), h2 = TRRD(b_ + 10240), l3 = TRRD(b_ + 12288), h3 = TRRD(b_ + 14336); \
        o[d0] = __builtin_amdgcn_mfma_f32_32x32x16_bf16(pa0, (bf16x8){l0[0], l0[1], l0[2], l0[3], h0[0], h0[1], h0[2], h0[3]}, o[d0], 0, 0, 0);   \
        o[d0] = __builtin_amdgcn_mfma_f32_32x32x16_bf16(pa1, (bf16x8){l1[0], l1[1], l1[2], l1[3], h1[0], h1[1], h1[2], h1[3]}, o[d0], 0, 0, 0);   \
        o[d0] = __builtin_amdgcn_mfma_f32_32x32x16_bf16(pa2, (bf16x8){l2[0], l2[1], l2[2], l2[3], h2[0], h2[1], h2[2], h2[3]}, o[d0], 0, 0, 0);   \
        o[d0] = __builtin_amdgcn_mfma_f32_32x32x16_bf16(pa3, (bf16x8){l3[0], l3[1], l3[2], l3[3], h3[0], h3[1], h3[2], h3[3]}, o[d0], 0, 0, 0); } while (0)
    PV_D0(0); PV_D0(1); PV_D0(2); PV_D0(3);
#undef PV_D0
#undef TRRD
}

struct AttnIO { const bf16_t* Q; const bf16_t* Q2; const bf16_t* K; const bf16_t* K2; const bf16_t* V; bf16_t* O; long long d2; float2* ml; const unsigned short* list; };

template <int MODE, int VAR = 0>
__device__ __forceinline__ void attn_item(char* lds, const AttnIO& io, int h, int qb, int cbase, int nvalid, float C2) {
    constexpr bool MLA = (MODE == 0);
    int tid_ = threadIdx.x; asm volatile("" : "+v"(tid_));
    const int tid = tid_, wid = __builtin_amdgcn_readfirstlane(tid >> 6), lane = tid & 63, r32 = lane & 31, hi = lane >> 5;
    const int q0 = qb * 256, qlo = q0 + wid * 32;
    int row = qlo + r32, ent = 0; bool valid = true;
    if constexpr (MODE == 2) { const int e = wid * 32 + r32; valid = e < nvalid; ent = (int)io.list[(size_t)cbase + (valid ? e : 0)]; row = ent & 0x3fff; }
    const int qm = row - 4 * hi;
    float* wsf = (float*)(lds + OFF_WS) + wid * 64; float* li_l = wsf; float* al_l = wsf + 32;
    bf16x8 qr[8]; const char* q2p = lds + OFF_Q2 + wid * 4096 + lane * 16;
#pragma unroll
    for (int d0 = 0; d0 < 8; ++d0) qr[d0] = *(const bf16x8*)(io.Q + (size_t)row * 1024 + h * 128 + d0 * 16 + hi * 8);
    if constexpr (MLA) {
#pragma unroll
        for (int d0 = 0; d0 < 4; ++d0) *(bf16x8*)(lds + OFF_Q2 + wid * 4096 + d0 * 1024 + lane * 16) = *(const bf16x8*)(io.Q2 + (size_t)row * 512 + h * 64 + d0 * 16 + hi * 8);
    }
    const int NT = MLA ? 4 * (qb + 1) : 4, kb0 = MLA ? 0 : q0;
    const int sr = tid >> 4, sc = (tid & 15) * 8, vst0 = v_st(sr, sc), vst1 = v_st(32 + sr, sc), kws = KSWZ(sr, sc * 2);
    const int s2r = tid >> 3, s2c = (tid & 7) * 8, k2ws = K2SWZ(s2r, s2c * 2);
    const __attribute__((address_space(3))) char* vbp = (const __attribute__((address_space(3))) char*)(unsigned)((int)(uintptr_t)(lds) + OFF_V + v_rd_base(lane));
    const bf16_t* Kh = io.K + h * 128 + sc; const bf16_t* Vh = io.V + h * 128 + sc; const bf16_t* K2h = MLA ? io.K2 + s2c : nullptr;
    float m_reg = -1e30f, l_reg = 0.f; f32x16 o[4] = {};
#define KEY0(t) (kb0 + (t) * 64)
#define LOADS_K(kk_) do { st_k0 = *(const bf16x8*)(Kh + (size_t)((kk_) + sr) * 1024); st_k1 = *(const bf16x8*)(Kh + (size_t)((kk_) + 32 + sr) * 1024);      \
                       if constexpr (MLA) st_k2 = *(const bf16x8*)(K2h + (size_t)((kk_) + s2r) * 64); } while (0)
#define LOADS_V(kk_) do { st_v0 = *(const bf16x8*)(Vh + (size_t)((kk_) + sr) * 1024); st_v1 = *(const bf16x8*)(Vh + (size_t)((kk_) + 32 + sr) * 1024); } while (0)
#define WRITES_K(bf) do { *(bf16x8*)(lds + OFF_K + (bf) * SHM_K + kws) = st_k0; *(bf16x8*)(lds + OFF_K + (bf) * SHM_K + kws + 32 * 256) = st_k1;           \
                        if constexpr (MLA) *(bf16x8*)(lds + OFF_K2 + (bf) * SHM_K2 + k2ws) = st_k2; } while (0)
#define WRITES_V(bf) do { *(bf16x8*)(lds + OFF_V + (bf) * SHM_V + vst0) = st_v0; *(bf16x8*)(lds + OFF_V + (bf) * SHM_V + vst1) = st_v1; } while (0)
#define RESC(a) do { if (__any((a) < 1.f)) { if (hi == 0) al_l[r32] = (a); asm volatile("s_waitcnt lgkmcnt(0)" ::: "memory");              \
                     for (int d_ = 0; d_ < 4; ++d_) for (int r = 0; r < 16; ++r) o[d_][r] *= al_l[crow(r, hi)]; } } while (0)
#define BAR() do { asm volatile("s_waitcnt lgkmcnt(0)" ::: "memory"); __builtin_amdgcn_s_barrier(); asm volatile("" ::: "memory"); } while (0)
    const int grp = wid >> 2;
    f32x16 p0, p1; bf16x8 pa0, pa1, pa2, pa3; float mn, al;
    bf16x8 st_k0, st_k1, st_v0, st_v1, st_k2;
#define ATT_STEP(t_, KB) do { const int t__ = (t_); const int k0__ = KEY0(t__);                                                                       \
        if (grp == 0) { if (t__ + 1 < NT) LOADS_K(KEY0(t__ + 1)); LOADS_V(k0__); } SBAR();                                                           \
        if (t__ > 0) pv_tile<(KB) ^ 1>(o, vbp, pa0, pa1, pa2, pa3); SBAR();                                                                          \
        qkt<KB, MLA>(p0, p1, lds, r32, hi, qr, q2p);                                                                                                 \
        if constexpr (MODE != 2) { if (k0__ + 63 > qlo) mask_tile(p0, p1, qm - k0__); }                                                              \
        SBAR(); if (grp == 1) { if (t__ + 1 < NT) WRITES_K((KB) ^ 1); WRITES_V(KB); }                                                                \
        BAR();                                                                                                                                       \
        if (grp == 1) { if (t__ + 2 < NT) LOADS_K(KEY0(t__ + 2)); if (t__ + 1 < NT) LOADS_V(KEY0(t__ + 1)); } SBAR();                                \
        partialSM(p0, p1, m_reg, mn, al, C2); finishSM(p0, p1, al, l_reg, pa0, pa1, pa2, pa3); RESC(al);                                            \
        SBAR(); if (grp == 0) { if (t__ + 1 < NT) WRITES_K((KB) ^ 1); WRITES_V(KB); }                                                                \
        BAR(); } while (0)
    { const int k00 = KEY0(0); LOADS_K(k00); WRITES_K(0); }
    if (grp == 1) { LOADS_K(KEY0(1)); LOADS_V(KEY0(0)); }
    BAR();
    if (grp == 1) BAR();
    for (int t = 0; t < NT; t += 2) { ATT_STEP(t, 0); ATT_STEP(t + 1, 1); }
    pv_tile<1>(o, vbp, pa0, pa1, pa2, pa3);
    BAR();
    if (grp == 0) BAR();
    int* ri_l = (int*)al_l;
    if (hi == 0) { li_l[r32] = l_reg; if constexpr (MODE == 2) ri_l[r32] = valid ? ent : -1; }
    asm volatile("s_waitcnt lgkmcnt(0)" ::: "memory");
    if constexpr (MODE != 0) { if (hi == 0 && valid) io.ml[((size_t)row * 8 + h) * 4 + (MODE == 1 ? 3 : (ent >> 14))] = make_float2(m_reg * C2, l_reg); }
#pragma unroll
    for (int r = 0; r < 16; ++r) { const int orow = crow(r, hi); const float rl = 1.0f / li_l[orow];
        bf16_t* Ow; bool st = true;
        if constexpr (MODE == 2) { const int info = ri_l[orow]; st = info >= 0; const int sl = info >> 14; Ow = io.O + ((long long)sl * (16384LL * 1024) + (sl == 2 ? io.d2 : 0LL)) + (size_t)(info & 0x3fff) * 1024 + h * 128; }
        else Ow = io.O + (size_t)(qlo + orow) * 1024 + h * 128;
#pragma unroll
        for (int d0 = 0; d0 < 4; ++d0) { const float v = o[d0][r] * rl; const float vn = __shfl_xor(v, 1);
            if ((VAR == 0 || C2 < 0.f) && st && (r32 & 1) == 0) *(unsigned*)(Ow + d0 * 32 + r32) = cvtpk(v, vn); } }
    BAR();
#undef KEY0
#undef LOADS_K
#undef LOADS_V
#undef WRITES_K
#undef WRITES_V
#undef RESC
#undef ATT_STEP
#undef BAR
}
}

struct WJob { const float* s1; const float* s2; const float* gain; bf16_t* dst; int ld, K, map, ntn; };
__device__ __forceinline__ const float* wsrc(int map, const float* s1, const float* s2, int n) {
    if (map == 0) return s1 + n;
    if (map == 1) {
        if (n < 2048) { const int hb = n & ~127, c = n & 127; const int d = c < 32 ? ((c >> 1) + 16 * (c & 1)) : c; return s1 + hb + d; }
        if (n < 3840) return s1 + n;
        if (n < 3904) { const int c = n - 3840; return s1 + 3840 + (c >> 1) + 32 * (c & 1); }
        if (n < 4096) return nullptr;
        return s1 + 3904 + (n - 4096); }
    if (map == 2) {
        if (n < 1024) return s1 + (n >> 7) * 192 + (n & 127);
        const int c = n - 1024, h = c >> 6, cc = c & 63; return s1 + h * 192 + 128 + (cc >> 1) + 32 * (cc & 1); }
    { const int t = n >> 8, r = n & 255; return r < 128 ? s1 + 128 * t + r : s2 + 128 * t + (r - 128); }
}
__device__ __forceinline__ bool wtile_load(const WJob& J, int tn, int tk, int lane, float (&v)[64]) {
    const float* sp = wsrc(J.map, J.s1, J.s2, tn * 64 + lane); const bool has = sp != nullptr; if (!has) sp = J.s1;
    const int k0 = tk * 64;
#pragma unroll
    for (int i = 0; i < 64; ++i) v[i] = __builtin_nontemporal_load(sp + (size_t)(k0 + i) * J.ld);
    return has;
}
__device__ __forceinline__ void wtile_store(const WJob& J, int tn, int tk, int lane, float (&v)[64], bool has) {
    const int k0 = tk * 64;
    if (J.gain) {
#pragma unroll
        for (int i = 0; i < 64; ++i) v[i] *= J.gain[k0 + i]; }
    if (!has) {
#pragma unroll
        for (int i = 0; i < 64; ++i) v[i] = 0.f; }
    bf16_t* d = J.dst + (size_t)(tn * 64 + lane) * J.K + k0;
#pragma unroll
    for (int i = 0; i < 8; ++i) { u32x4 w; w.x = cvt_pk_bf16(v[8 * i], v[8 * i + 1]); w.y = cvt_pk_bf16(v[8 * i + 2], v[8 * i + 3]); w.z = cvt_pk_bf16(v[8 * i + 4], v[8 * i + 5]); w.w = cvt_pk_bf16(v[8 * i + 6], v[8 * i + 7]);
        *(u32x4*)(d + 8 * i) = w; }
}
__device__ __forceinline__ WJob wjob_of(const Params& P, unsigned char* ws, int t, int& lt) {
    if (t < 4096) { lt = t; return WJob{P.w_in, nullptr, nullptr, (bf16_t*)(ws + WS_WIN), 8000, 2048, 1, 128}; }
    if (t < 4288) { lt = t - 4096; return WJob{P.w_uq, nullptr, P.q_norm, (bf16_t*)(ws + WS_WUQ), 1536, 512, 2, 24}; }
    if (t < 4416) { lt = t - 4288; return WJob{P.w_ukv, nullptr, P.kv_norm, (bf16_t*)(ws + WS_WUKV), 2048, 256, 0, 32}; }
    if (t < 4928) { lt = t - 4416; return WJob{P.w_ba, nullptr, nullptr, (bf16_t*)(ws + WS_WBR), 2048, 1024, 0, 32}; }
    if (t < 5440) { lt = t - 4928; return WJob{P.w_bb, nullptr, nullptr, (bf16_t*)(ws + WS_WBR) + (size_t)2048 * 1024, 2048, 1024, 0, 32}; }
    if (t < 6464) { lt = t - 5440; return WJob{P.w_out, nullptr, nullptr, (bf16_t*)(ws + WS_WOUT), 2048, 2048, 0, 32}; }
    if (t < 12096) { lt = t - 6464; return WJob{P.w_gate, P.w_up, P.ffn_norm, (bf16_t*)(ws + WS_WGU), 5632, 2048, 3, 176}; }
    lt = t - 12096; return WJob{P.w_down, nullptr, nullptr, (bf16_t*)(ws + WS_WDN), 2048, 5632, 0, 32};
}
__device__ __forceinline__ void sincos_rev(float ang, float& c, float& s) {
    const double rev = (double)ang * 0.15915494309189535; const float fr = (float)(rev - __builtin_rint(rev));
    c = __builtin_amdgcn_cosf(fr); s = __builtin_amdgcn_sinf(fr); }
__device__ __forceinline__ void phase0(const Params& P, char* lds) {
    const int tid = threadIdx.x, lane = tid & 63, wid = tid >> 6, gtid = blockIdx.x * 512 + tid, gsz = gridDim.x * 512;
    unsigned char* ws = P.ws;
    { float* z = (float*)(ws + WS_KMS); for (int i = gtid; i < 65536 + 65536 + 1024; i += gsz) z[i] = 0.f; }
    { float* csa = (float*)(ws + WS_CSA); float* csb = (float*)(ws + WS_CSB);
#define ROPE_TAB(T_, W_, F_, B_) do { _Pragma("unroll") for (int q_ = 0; q_ < 8; ++q_) { float c_, s_; sincos_rev(pf * F_[(B_) + q_], c_, s_);               \
          T_[(size_t)row * (W_) + 2 * ((B_) + q_)] = c_; T_[(size_t)row * (W_) + 2 * ((B_) + q_) + 1] = s_; } } while (0)
      for (int it = gtid; it < S_ * 6; it += gsz) { const int row = it / 6, g = it - row * 6; const float pf = (float)P.pos[row];
          switch (g) { case 0: ROPE_TAB(csa, 32, P.invf_a, 0); break; case 1: ROPE_TAB(csa, 32, P.invf_a, 8); break;
                       case 2: ROPE_TAB(csb, 64, P.invf_b, 0); break; case 3: ROPE_TAB(csb, 64, P.invf_b, 8); break;
                       case 4: ROPE_TAB(csb, 64, P.invf_b, 16); break; default: ROPE_TAB(csb, 64, P.invf_b, 24); break; } }
#undef ROPE_TAB
    }
    { bf16_t* xn = (bf16_t*)(ws + WS_ACT + A_XN);
      for (int row = blockIdx.x * 8 + wid; row < S_; row += gridDim.x * 8) { const f32x4* xr = (const f32x4*)(P.x + (size_t)row * DM); f32x4 v[8]; float ss = 0.f;
#pragma unroll
          for (int i = 0; i < 8; ++i) { v[i] = __builtin_nontemporal_load(xr + lane + 64 * i); ss += sq4(v[i]); }
#pragma unroll
          for (int off = 32; off >= 1; off >>= 1) ss += __shfl_xor(ss, off);
          const float r = rstd_of(ss, 1.0f / 2048.0f);
#pragma unroll
          for (int i = 0; i < 8; ++i) { const f32x4 g = ((const f32x4*)P.attn_norm)[lane + 64 * i]; const f32x4 y = v[i] * r * g;
              uint2 w; w.x = cvt_pk_bf16(y[0], y[1]); w.y = cvt_pk_bf16(y[2], y[3]); ((uint2*)(xn + (size_t)row * DM))[lane + 64 * i] = w; } } }
    {
      const int nw = gridDim.x * 8; int t = blockIdx.x * 8 + wid;
      if (t < 14912) { int lt; WJob J = wjob_of(P, ws, t, lt); float v[64]; bool has = wtile_load(J, lt % J.ntn, lt / J.ntn, lane, v);
          for (;;) { const int t2 = t + nw; int lt2 = 0; WJob J2 = J; float w[64]; bool has2 = false;
              if (t2 < 14912) { J2 = wjob_of(P, ws, t2, lt2); has2 = wtile_load(J2, lt2 % J2.ntn, lt2 / J2.ntn, lane, w); }
              wtile_store(J, lt % J.ntn, lt / J.ntn, lane, v, has);
              if (t2 >= 14912) break;
#pragma unroll
              for (int i = 0; i < 64; ++i) v[i] = w[i];
              J = J2; lt = lt2; has = has2; t = t2; } } }
}
constexpr int L_TRI = 256 * 2016;
__host__ __device__ __forceinline__ int l_tri(int j) { return 256 * (63 * j - (j * (j - 1)) / 2); }
__device__ __forceinline__ void moba_gate(const Params& P, char* lds) {
    const int tid = threadIdx.x; float* km = (float*)lds; unsigned char* ws = P.ws;
    const float* kms = (const float*)(ws + WS_KMS); const bf16_t* qa = (const bf16_t*)(ws + WS_ACT + A_QA); unsigned* lcnt = (unsigned*)(ws + WS_CTL) + 256; unsigned short* list = (unsigned short*)(ws + WS_ACT + A_LIST);
    for (int item = blockIdx.x; item < 256; item += gridDim.x) { const int h = item & 7, pp = item >> 3;
        __syncthreads();
        for (int i = tid; i < 8192; i += 512) km[i] = kms[h * 8192 + i] * (1.0f / 256.0f);
        __syncthreads();
        const int row = tid < 256 ? pp * 256 + tid : (63 - pp) * 256 + (tid - 256), blk = row >> 8, nblk = __builtin_amdgcn_readfirstlane(blk);
        const u32x4* qp = (const u32x4*)(qa + (size_t)row * 1024 + h * 128); u32x4 q[16];
#pragma unroll
        for (int i = 0; i < 16; ++i) q[i] = qp[i];
        float b1 = -__builtin_inff(), b2 = b1, b3 = b1; int i1 = 0, i2 = 0, i3 = 0;
        for (int n = 0; n < nblk; ++n) { const f32x4* kr = (const f32x4*)(km + n * 128); float a0 = 0.f, a1 = 0.f;
#pragma unroll
            for (int i = 0; i < 16; ++i) { const f32x4 ka = kr[2 * i], kb = kr[2 * i + 1]; const u32x4 qq = q[i];
                a0 += bflo(qq.x) * ka[0] + bfhi(qq.x) * ka[1] + bflo(qq.y) * ka[2] + bfhi(qq.y) * ka[3];
                a1 += bflo(qq.z) * kb[0] + bfhi(qq.z) * kb[1] + bflo(qq.w) * kb[2] + bfhi(qq.w) * kb[3]; }
            const float g = a0 + a1;
            if (g > b1) { b3 = b2; i3 = i2; b2 = b1; i2 = i1; b1 = g; i1 = n; }
            else if (g > b2) { b3 = b2; i3 = i2; b2 = g; i2 = n; }
            else if (g > b3) { b3 = g; i3 = n; } }
        if (blk >= 1) { const unsigned p = atomicAdd(lcnt + h * 64 + i1, 1u); list[(size_t)h * L_TRI + l_tri(i1) + p] = (unsigned short)(row); }
        if (blk >= 2) { const unsigned p = atomicAdd(lcnt + h * 64 + i2, 1u); list[(size_t)h * L_TRI + l_tri(i2) + p] = (unsigned short)(row | (1 << 14)); }
        if (blk >= 3) { const unsigned p = atomicAdd(lcnt + h * 64 + i3, 1u); list[(size_t)h * L_TRI + l_tri(i3) + p] = (unsigned short)(row | (2 << 14)); } }
}
__device__ __forceinline__ void grid_bar(unsigned* cnt, unsigned& target, unsigned G) {
    asm volatile("s_waitcnt vmcnt(0)" ::: "memory");
    __syncthreads();
    target += G;
    if (threadIdx.x == 0) {
        __builtin_amdgcn_fence(__ATOMIC_RELEASE, "agent");
        asm volatile("s_waitcnt vmcnt(0)" ::: "memory");
        __hip_atomic_fetch_add(cnt, 1u, __ATOMIC_RELAXED, __HIP_MEMORY_SCOPE_AGENT);
        while (__hip_atomic_load(cnt, __ATOMIC_RELAXED, __HIP_MEMORY_SCOPE_AGENT) < target) __builtin_amdgcn_s_sleep(1);
        __builtin_amdgcn_fence(__ATOMIC_ACQUIRE, "agent");
        asm volatile("s_waitcnt vmcnt(0)" ::: "memory");
    }
    __syncthreads();
}
constexpr int LDS_BYTES = pg8::STAGE_BYTES;
__global__ void __launch_bounds__(512, 2) hybrid_fwd(Params P) {
    extern __shared__ __attribute__((aligned(16))) unsigned char lds_raw[];
    char* lds = (char*)lds_raw; PG8_LAS unsigned char* ldsg = (PG8_LAS unsigned char*)lds_raw;
    unsigned char* ws = P.ws; unsigned char* wa = ws + WS_ACT;
    const int tid = threadIdx.x, G = gridDim.x, c = blockIdx.x;
    const int lo = P.ph_lo, hi = P.ph_hi;
    float* ssq = (float*)(ws + WS_SSQ); float* ssq_q = ssq, * ssq_kv = ssq + S_, * ssq_h = ssq + 2 * S_, * ssq_o = ssq + 3 * S_;
    bf16_t* gates = (bf16_t*)P.out;
#ifndef PHMASK
#define PHMASK 0x3ff
#endif
#define IN(k) (((PHMASK >> (k)) & 1) && lo <= (k) && (k) < hi)
    unsigned bar_target = 0; unsigned* bar_cnt = (unsigned*)(ws + WS_BAR);
#define SEAM(k) do { if (IN(k) && IN((k) + 1)) { if (lo < 0) cg::this_grid().sync(); else grid_bar(bar_cnt, bar_target, (unsigned)G); } } while (0)
#ifndef NREP0
#define NREP0 1
#endif
#ifndef NREP3
#define NREP3 1
#endif
#ifndef NREP7
#define NREP7 1
#endif
    if (IN(0)) for (int rep = 0; rep < NREP0; ++rep) { if (rep) cg::this_grid().sync(); phase0(P, lds); }
    SEAM(0);
    if (IN(1)) {
        pg8::Gemm g{(const bf16_t*)(wa + A_XN), (const bf16_t*)(ws + WS_WIN), S_, 8192, 2048}; pg8::StaticOrder so; so.init(S_, 8192, G, c);
        EpiProj E{(bf16_t*)(wa + A_QA), (bf16_t*)(wa + A_KA), (bf16_t*)(wa + A_VA), (bf16_t*)(wa + A_CQ), (bf16_t*)(wa + A_CKV), (bf16_t*)(wa + A_KRP), gates,
                  (const float*)(ws + WS_CSA), (const float*)(ws + WS_CSB), (float*)(ws + WS_KMS), ssq_q, ssq_kv};
        pg8::gemm_phase<EpiProj, pg8::StaticOrder, false>(ldsg, g, so, E, nullptr);
    }
    SEAM(1);
    if (IN(2)) {
#ifndef NO_G2A
        { pg8::Gemm g{(const bf16_t*)(wa + A_CQ), (const bf16_t*)(ws + WS_WUQ), S_, 1536, 512}; pg8::StaticOrder so; so.init(S_, 1536, G, c);
          EpiQ E{(bf16_t*)(wa + A_QN), (bf16_t*)(wa + A_QRP), (const float*)(ws + WS_CSB), ssq_q};
          pg8::gemm_phase<EpiQ, pg8::StaticOrder, false>(ldsg, g, so, E, nullptr); }
#endif
#ifndef NO_G2B
        { int kk = 256; asm volatile("" : "+s"(kk));
          pg8::Gemm g{(const bf16_t*)(wa + A_CKV), (const bf16_t*)(ws + WS_WUKV), S_, 2048, kk}; pg8::StaticOrder so; so.init(S_, 2048, G, c);
          EpiKV E{(bf16_t*)(wa + A_KN), (bf16_t*)(wa + A_VB), ssq_kv};
          pg8::gemm_phase<EpiKV, pg8::StaticOrder, false>(ldsg, g, so, E, nullptr); }
#endif
#ifndef NO_GATE
        moba_gate(P, lds);
#endif
    }
    SEAM(2);
    if (IN(3)) {
        for (int rep = 0; rep < NREP3; ++rep) { if (rep) cg::this_grid().sync();
        unsigned* ctr = (unsigned*)(ws + WS_CTL) + rep * 8; int* itp = (int*)(lds + att::OFF_MISC + 64 + 67 * 4);
        const unsigned* lcnt = (unsigned*)(ws + WS_CTL) + 256; int* pre = (int*)(lds + att::OFF_Q2);
        bf16_t* ya = (bf16_t*)(wa + A_Y);
        att::AttnIO mla{(const bf16_t*)(wa + A_QN), (const bf16_t*)(wa + A_QRP), (const bf16_t*)(wa + A_KN), (const bf16_t*)(wa + A_KRP), (const bf16_t*)(wa + A_VB), ya + (size_t)S_ * 1024, 0LL, nullptr, nullptr};
        att::AttnIO mob{(const bf16_t*)(wa + A_QA), nullptr, (const bf16_t*)(wa + A_KA), nullptr, (const bf16_t*)(wa + A_VA), ya, 0LL, (float2*)(wa + A_ML), nullptr};
        att::AttnIO gat{(const bf16_t*)(wa + A_QA), nullptr, (const bf16_t*)(wa + A_KA), nullptr, (const bf16_t*)(wa + A_VA), (bf16_t*)(wa + A_P0), (long long)((bf16_t*)(ws + WS_WIN) - ((bf16_t*)(wa + A_P0) + 2 * (size_t)S_ * 1024)), (float2*)(wa + A_ML), (const unsigned short*)(wa + A_LIST)};
        unsigned* mq = (unsigned*)(ws + WS_CTL) + 32; unsigned* gq = (unsigned*)(ws + WS_CTL) + 48; const int x0 = (int)(blockIdx.x & 7);
        for (int kx = 0; kx < 8; ++kx) { const int hx = (x0 + kx) & 7;
            for (;;) {
                if (tid == 0) *itp = (int)atomicAdd(mq + hx, 1u);
                __syncthreads();
                const int it = __builtin_amdgcn_readfirstlane(*itp);
                __syncthreads();
                if (it >= 64) break;
                att::attn_item<0>(lds, mla, hx, 63 - it, 0, 0, 1.4426950408889634f * 0.07216878364870323f);
            } }
        { const int hh = tid >> 6, jj = tid & 63; int* tot = pre + 512;
          const int v = jj < 63 ? (int)((lcnt[hh * 64 + jj] + 255u) >> 8) : 0; int inc = v;
#pragma unroll
          for (int off = 1; off < 64; off <<= 1) { const int n_ = __shfl_up(inc, off); if (jj >= off) inc += n_; }
          if (jj == 63) tot[hh] = inc;
          __syncthreads();
          int base = 0;
#pragma unroll
          for (int q = 0; q < 8; ++q) base += (q < hh) ? tot[q] : 0;
          if (jj < 63) pre[hh * 63 + jj] = base + inc - v;
          if (tid == 511) pre[504] = base + inc; }
        __syncthreads();
        { const int ngat = __builtin_amdgcn_readfirstlane(pre[504]);
          for (int it = c; it < ngat; it += G) { int lo_ = 0, hi_ = 503;
              while (lo_ < hi_) { const int mid = (lo_ + hi_ + 1) >> 1; if (__builtin_amdgcn_readfirstlane(pre[mid]) <= it) lo_ = mid; else hi_ = mid - 1; }
              const int pr = lo_, h = pr / 63, j = pr % 63, cch = it - __builtin_amdgcn_readfirstlane(pre[pr]); const int cnt = (int)lcnt[h * 64 + j];
              const int nv = cnt - cch * 256 < 256 ? cnt - cch * 256 : 256;
              att::attn_item<2>(lds, gat, h, j, h * L_TRI + l_tri(j) + cch * 256, nv, 1.4426950408889634f * 0.08838834764831845f); } }
        for (int it = c; it < 512; it += G)
            att::attn_item<1>(lds, mob, it & 7, it >> 3, 0, 0, 1.4426950408889634f * 0.08838834764831845f);
        }
    }
    SEAM(3);
    if (IN(4)) {
        const float2* ml = (const float2*)(wa + A_ML); bf16_t* ya = (bf16_t*)(wa + A_Y);
        const bf16_t* pp0 = (const bf16_t*)(wa + A_P0); const bf16_t* pp1 = (const bf16_t*)(wa + A_P1); const bf16_t* pp2 = (const bf16_t*)(ws + WS_WIN);
        const int lane = tid & 63, wid = tid >> 6, h = lane >> 3;
#define MRG_ACC(a_, b_, w_) do { const float w__ = (w_);                                                                                      \
            c0[0] += w__ * bflo(a_.x); c0[1] += w__ * bfhi(a_.x); c0[2] += w__ * bflo(a_.y); c0[3] += w__ * bfhi(a_.y);                          \
            c1[0] += w__ * bflo(a_.z); c1[1] += w__ * bfhi(a_.z); c1[2] += w__ * bflo(a_.w); c1[3] += w__ * bfhi(a_.w);                          \
            c2[0] += w__ * bflo(b_.x); c2[1] += w__ * bfhi(b_.x); c2[2] += w__ * bflo(b_.y); c2[3] += w__ * bfhi(b_.y);                          \
            c3[0] += w__ * bflo(b_.z); c3[1] += w__ * bfhi(b_.z); c3[2] += w__ * bflo(b_.w); c3[3] += w__ * bfhi(b_.w); } while (0)
#define MRG_LD(ptr, A_, B_) do { A_ = *(const u32x4*)((ptr) + eo); B_ = *(const u32x4*)((ptr) + eo + 8); } while (0)
        for (int row = c * 8 + wid; row < S_; row += G * 8) { const int blk = row >> 8; const size_t mo = ((size_t)row * 8 + h) * 4, eo = (size_t)row * 1024 + lane * 16;
            const float2 s3 = ml[mo + 3]; float2 s0 = make_float2(-1e30f, 0.f), s1 = s0, s2 = s0;
            u32x4 ya_a, ya_b, p0a = {0, 0, 0, 0}, p0b = p0a, p1a = p0a, p1b = p0a, p2a = p0a, p2b = p0a;
            MRG_LD(ya, ya_a, ya_b);
            if (blk >= 1) { s0 = ml[mo]; MRG_LD(pp0, p0a, p0b); } if (blk >= 2) { s1 = ml[mo + 1]; MRG_LD(pp1, p1a, p1b); } if (blk >= 3) { s2 = ml[mo + 2]; MRG_LD(pp2, p2a, p2b); }
            const float M = fmaxf(fmaxf(s3.x, s0.x), fmaxf(s1.x, s2.x));
            const float w3 = s3.y * __builtin_amdgcn_exp2f(s3.x - M), w0 = s0.y * __builtin_amdgcn_exp2f(s0.x - M), w1 = s1.y * __builtin_amdgcn_exp2f(s1.x - M), w2 = s2.y * __builtin_amdgcn_exp2f(s2.x - M);
            f32x4 c0 = {0.f, 0.f, 0.f, 0.f}, c1 = c0, c2 = c0, c3 = c0;
            MRG_ACC(ya_a, ya_b, w3); MRG_ACC(p0a, p0b, w0); MRG_ACC(p1a, p1b, w1); MRG_ACC(p2a, p2b, w2);
            const float inv = 1.0f / (w3 + w0 + w1 + w2);
            st8(ya + eo, c0 * inv, c1 * inv); st8(ya + eo + 8, c2 * inv, c3 * inv); }
#undef MRG_LD
#undef MRG_ACC
    }
    SEAM(4);
    if (IN(5)) {
        pg8::Gemm g{(const bf16_t*)(wa + A_Y), (const bf16_t*)(ws + WS_WBR), 2 * S_, 4096, 1024}; BranchOrder bo; bo.init(G, c);
        EpiBranch E{gates, (bf16_t*)(wa + A_T), (bf16_t*)(wa + A_MIX)};
        pg8::gemm_phase<EpiBranch, BranchOrder, false>(ldsg, g, bo, E, nullptr);
    }
    SEAM(5);
    if (IN(6)) {
        pg8::Gemm g{(const bf16_t*)(wa + A_MIX), (const bf16_t*)(ws + WS_WOUT), S_, 2048, 2048}; pg8::StaticOrder so; so.init(S_, 2048, G, c);
        EpiOut E{P.x, (float*)(wa + A_HF), (bf16_t*)(wa + A_HB), ssq_h};
        pg8::gemm_phase<EpiOut, pg8::StaticOrder, false>(ldsg, g, so, E, nullptr);
    }
    SEAM(6);
    if (IN(7)) {
        pg8::Gemm g{(const bf16_t*)(wa + A_HB), (const bf16_t*)(ws + WS_WGU), S_, 11264, 2048}; pg8::StaticOrder so; so.init(S_, 11264, G, c);
        EpiGU E{(bf16_t*)(wa + A_ACTV), ssq_h};
        for (int rep = 0; rep < NREP7; ++rep) { if (rep) cg::this_grid().sync(); pg8::gemm_phase<EpiGU, pg8::StaticOrder, false>(ldsg, g, so, E, nullptr); }
    }
    SEAM(7);
    if (IN(8)) {
        pg8::Gemm g{(const bf16_t*)(wa + A_ACTV), (const bf16_t*)(ws + WS_WDN), S_, 2048, DFF}; pg8::StaticOrder so; so.init(S_, 2048, G, c);
        EpiDown E{(const float*)(wa + A_HF), P.out, ssq_o};
        pg8::gemm_phase<EpiDown, pg8::StaticOrder, false>(ldsg, g, so, E, nullptr);
    }
    SEAM(8);
    if (IN(9)) {
        const int lane = tid & 63, wid = tid >> 6;
        for (int row = c * 8 + wid; row < S_; row += G * 16) { const int row2 = row + G * 8; const bool has2 = row2 < S_;
            const float r = rstd_of(ssq_o[row], 1.0f / 2048.0f), r2 = rstd_of(ssq_o[has2 ? row2 : row], 1.0f / 2048.0f);
            f32x4* op = (f32x4*)(P.out + (size_t)row * DM); f32x4* op2 = (f32x4*)(P.out + (size_t)(has2 ? row2 : row) * DM); f32x4 va[8], vb[8];
#pragma unroll
            for (int i = 0; i < 8; ++i) { va[i] = op[lane + 64 * i]; vb[i] = op2[lane + 64 * i]; }
#pragma unroll
            for (int i = 0; i < 8; ++i) { const f32x4 g = ((const f32x4*)P.final_norm)[lane + 64 * i]; op[lane + 64 * i] = va[i] * r * g; if (has2) op2[lane + 64 * i] = vb[i] * r2 * g; } }
    }
#undef IN
#undef SEAM
}

#ifndef MK_FUSED
#define MK_FUSED 0
#endif
extern "C" void kernel_launch(void* const* d_in, const int* in_sizes, int n_in, void* d_out, int out_size, void* d_ws, size_t ws_size, hipStream_t stream) {
    static int grid = 0;
    if (grid == 0) {
        int dev = 0, cus = 0, per_cu = 0;
        (void)hipGetDevice(&dev); (void)hipDeviceGetAttribute(&cus, hipDeviceAttributeMultiprocessorCount, dev);
        if (hipFuncSetAttribute((const void*)hybrid_fwd, hipFuncAttributeMaxDynamicSharedMemorySize, LDS_BYTES) != hipSuccess) fprintf(stderr, "hipFuncSetAttribute failed\n");
        if (hipOccupancyMaxActiveBlocksPerMultiprocessor(&per_cu, (const void*)hybrid_fwd, 512, LDS_BYTES) != hipSuccess || per_cu < 1) { fprintf(stderr, "occupancy query: %d\n", per_cu); per_cu = 1; }
        (void)hipGetLastError();
        if (cus <= 0) cus = 256;
        grid = cus * (per_cu > 1 ? 1 : per_cu);
        if (ws_size < WS_END) fprintf(stderr, "kernel_launch: workspace %zu < %zu\n", ws_size, (size_t)WS_END);
    }
    (void)hipMemsetAsync((char*)d_ws + WS_BAR, 0, 256, stream);
    Params p{};
    p.x = (const float*)d_in[0]; p.pos = (const int*)d_in[1]; p.attn_norm = (const float*)d_in[2]; p.w_in = (const float*)d_in[3]; p.q_norm = (const float*)d_in[4];
    p.w_uq = (const float*)d_in[5]; p.kv_norm = (const float*)d_in[6]; p.w_ukv = (const float*)d_in[7]; p.w_ba = (const float*)d_in[8]; p.w_bb = (const float*)d_in[9];
    p.w_out = (const float*)d_in[10]; p.ffn_norm = (const float*)d_in[11]; p.w_gate = (const float*)d_in[12]; p.w_up = (const float*)d_in[13]; p.w_down = (const float*)d_in[14];
    p.final_norm = (const float*)d_in[15]; p.out = (float*)d_out; p.ws = (unsigned char*)d_ws;
    for (int i = 0; i < 16; ++i) p.invf_a[i] = (float)std::pow(500000.0, -(double)(2 * i) / 32.0);
    for (int i = 0; i < 32; ++i) p.invf_b[i] = (float)std::pow(500000.0, -(double)(2 * i) / 64.0);
#if MK_FUSED
    p.ph_lo = 0; p.ph_hi = 10;
    void* args[] = {&p};
    hipError_t e = hipLaunchCooperativeKernel((const void*)hybrid_fwd, dim3(grid), dim3(512), args, LDS_BYTES, stream);
    if (e != hipSuccess) fprintf(stderr, "cooperative launch failed: %s (grid %d)\n", hipGetErrorString(e), grid);
#else
    for (int ph = 0; ph < 10; ++ph) { p.ph_lo = ph; p.ph_hi = ph + 1; hipLaunchKernelGGL(hybrid_fwd, dim3(grid), dim3(512), LDS_BYTES, stream, p); }

#endif
}
```

```cpp
#define MK_FUSED 1
#include <hip/hip_runtime.h>
#include <hip/hip_cooperative_groups.h>
#include <cstdio>
#include <cstdint>
#include <cmath>
namespace cg = cooperative_groups;
namespace pg8 {
#define PG8_LAS __attribute__((address_space(3)))
typedef unsigned short bf16_t;
typedef short bf16x8 __attribute__((ext_vector_type(8)));
typedef float f32x4 __attribute__((ext_vector_type(4)));
typedef unsigned u32x4 __attribute__((ext_vector_type(4)));
constexpr int BM = 256, BK = 64, HALF = 128, HTB = HALF * BK * 2  , STAGE_BYTES = 8 * HTB, NXCD = 8, WGM = 8;

__host__ __device__ __forceinline__ int lds_byte(int r, int c) { const int st = (r >> 4) * 2 + (c >> 5), rr = r & 15, cc = c & 31, ob = rr * 64 + cc * 2; return st * 1024 + (ob ^ (((ob >> 9) & 1) << 5)); }
__host__ __device__ __forceinline__ void stage_rc(int b, int& R, int& C) { const int st = b / 1024, sb = b % 1024, swz = sb ^ (((sb >> 9) & 1) << 5); R = (st >> 1) * 16 + swz / 64; C = (st & 1) * 32 + (swz % 64) / 2; }
__host__ __device__ __forceinline__ int perm32(int rho) { const int n = rho >> 4, i = rho & 15; return 8 * (i >> 2) + 4 * n + (i & 3); }

struct Unit { int pm, pn; };
struct Gemm { const bf16_t* A; const bf16_t* Bt; int M, N, K; };

struct StaticOrder {
    int nM, nN, nwg, G, c;
    __host__ __device__ void init(int M, int N, int G_, int c_) { nM = M / BM; nN = N / BM; nwg = nM * nN; G = G_; c = c_; }
    __host__ __device__ bool next(int i, Unit& u) const {
        const long L = (long)i * G + c; if (L >= nwg) return false;
        int wgid = (int)L; { const int q = nwg / NXCD, r = nwg % NXCD, xcd = wgid % NXCD, off = wgid / NXCD; wgid = (xcd < r ? xcd * (q + 1) : r * (q + 1) + (xcd - r) * q) + off; }
        const int nig = WGM * nN, gid = wgid / nig, fm = gid * WGM, gsz = (nM - fm) < WGM ? (nM - fm) : WGM;
        u.pm = fm + ((wgid % nig) % gsz); u.pn = (wgid % nig) / gsz; return true;
    }
    __device__ __forceinline__ void a_ready(const Unit&) const {}
    __device__ __forceinline__ void done(const Unit&) const {}
};
typedef __bf16 bf16x2_n __attribute__((ext_vector_type(2)));
__device__ __forceinline__ unsigned cvt_pk_bf16(float lo, float hi) { bf16x2_n v = {(__bf16)lo, (__bf16)hi}; return __builtin_bit_cast(unsigned, v); }
typedef float f32x2 __attribute__((ext_vector_type(2)));
template <class Epi, class Sched, bool STAMP = false>
__device__ __forceinline__ void gemm_phase(PG8_LAS unsigned char* lds, const Gemm g, const Sched& S, const Epi& E, unsigned long long* stamps) {
    const int tid = threadIdx.x, wid = __builtin_amdgcn_readfirstlane(tid >> 6), lane = tid & 63, wr = wid >> 2, wc = wid & 3, fr = lane & 15, fq = lane >> 4;
    const int K = g.K, nt = K / BK;
    int ts_lo = 0, ts_hi = 0, nts = 0; const unsigned long long rt_entry = STAMP ? (unsigned long long)wall_clock64() : 0ull;
#define PG8_STAMP() do { if (STAMP && wid == 0 && nts < 64) { const unsigned long long _c = (unsigned long long)clock64(); \
        ts_lo = (lane == nts) ? (int)(unsigned)_c : ts_lo; ts_hi = (lane == nts) ? (int)(unsigned)(_c >> 32) : ts_hi; ++nts; } } while (0)
    PG8_STAMP();
    unsigned voffA[2], voffB[2];
#pragma unroll
    for (int i = 0; i < 2; ++i) { int R, C; stage_rc(tid * 16 + i * 8192, R, C); const int Rb = Epi::PERM ? ((R & ~31) + perm32(R & 31)) : R;
        voffA[i] = (unsigned)(R * K + C) * 2u; voffB[i] = (unsigned)(Rb * K + C) * 2u; }
    const size_t kstep = (size_t)(BK * 2);
    const size_t hstep = (size_t)HALF * K * 2;
    const size_t tstep = 2 * hstep;
    const unsigned ldsw = (unsigned)wid * 1024u;
    const int aoff = lds_byte(wr * 64 + fr, fq * 8), boff = lds_byte(wc * 32 + fr, fq * 8);
#define PG8_SA(b, h) (((b) * 2 + (h)) * HTB)
#define PG8_SB(b, h) ((4 + (b) * 2 + (h)) * HTB)
#define PG8_STAGE(bufoff, gbase, voff) do { _Pragma("unroll") for (int _i = 0; _i < 2; ++_i) \
        __builtin_amdgcn_global_load_lds((const unsigned*)((const char*)(gbase) + (voff)[_i]), (PG8_LAS unsigned*)(lds + (bufoff) + ldsw + _i * 8192), 16, 0, 0); } while (0)
#define PG8_LDA(dst, b, h) do { _Pragma("unroll") for (int m = 0; m < 4; ++m) _Pragma("unroll") for (int k = 0; k < 2; ++k) dst[m][k] = *(const PG8_LAS bf16x8*)(lds + PG8_SA(b, h) + aoff + m * 2048 + k * 1024); } while (0)
#define PG8_LDB(dst, b, h) do { _Pragma("unroll") for (int n = 0; n < 2; ++n) _Pragma("unroll") for (int k = 0; k < 2; ++k) dst[n][k] = *(const PG8_LAS bf16x8*)(lds + PG8_SB(b, h) + boff + n * 2048 + k * 1024); } while (0)
#define PG8_MMA(ai, bj, At, Bt) do { __builtin_amdgcn_s_setprio(1); _Pragma("unroll") for (int m = 0; m < 4; ++m) _Pragma("unroll") for (int n = 0; n < 2; ++n) _Pragma("unroll") for (int k = 0; k < 2; ++k) \
        acc[ai][bj][m][n] = __builtin_amdgcn_mfma_f32_16x16x32_bf16(Bt[n][k], At[m][k], acc[ai][bj][m][n], 0, 0, 0); __builtin_amdgcn_s_setprio(0); } while (0)
#define PG8_WAIT_V(n) asm volatile("s_waitcnt vmcnt(" #n ")" ::: "memory")
#define PG8_WAIT_L(n) asm volatile("s_waitcnt lgkmcnt(" #n ")" ::: "memory")
#define PG8_BAR __builtin_amdgcn_s_barrier()
#define PG8_SCHED __builtin_amdgcn_sched_barrier(0)
    Unit cur, nxt; int ui = 0;
    if (!S.next(0, cur)) return;
    f32x4 acc[2][2][4][2];
#pragma unroll
    for (int a = 0; a < 2; ++a)
#pragma unroll
        for (int b = 0; b < 2; ++b)
#pragma unroll
            for (int m = 0; m < 4; ++m)
#pragma unroll
                for (int n = 0; n < 2; ++n) acc[a][b][m][n] = (f32x4){0.f, 0.f, 0.f, 0.f};
    bf16x8 At[4][2], B0[2][2], B1[2][2];
    const char* cA = (const char*)g.A + (size_t)cur.pm * tstep; const char* cB = (const char*)g.Bt + (size_t)cur.pn * tstep;
    S.a_ready(cur);
    PG8_STAGE(PG8_SB(0, 0), cB, voffB); PG8_STAGE(PG8_SA(0, 0), cA, voffA); PG8_STAGE(PG8_SB(0, 1), cB + hstep, voffB); PG8_STAGE(PG8_SA(0, 1), cA + hstep, voffA);
    if (wr == 1) PG8_BAR;
    PG8_WAIT_V(4); PG8_BAR;
    PG8_STAGE(PG8_SB(1, 0), cB + kstep, voffB); PG8_STAGE(PG8_SA(1, 0), cA + kstep, voffA); PG8_STAGE(PG8_SB(1, 1), cB + hstep + kstep, voffB);
    PG8_WAIT_V(6); PG8_BAR;
    PG8_STAMP();
    for (;;) {
        const bool has_next = S.next(ui + 1, nxt);
        const char* nA = has_next ? (const char*)g.A + (size_t)nxt.pm * tstep : cA; const char* nB = has_next ? (const char*)g.Bt + (size_t)nxt.pn * tstep : cB;
        for (int t = 0; t < nt; t += 2) {
            const bool last = (t == nt - 2);
            const char* a1 = cA + (size_t)(t + 1) * kstep;
            const char* a2 = last ? nA : cA + (size_t)(t + 2) * kstep; const char* b2 = last ? nB : cB + (size_t)(t + 2) * kstep;
            const char* a3 = a2 + kstep; const char* b3 = b2 + kstep;
            if (last && has_next) S.a_ready(nxt);
            PG8_LDB(B0, 0, 0); PG8_SCHED; PG8_LDA(At, 0, 0); PG8_STAGE(PG8_SA(1, 1), a1 + hstep, voffA);
            PG8_WAIT_L(8); PG8_BAR; PG8_WAIT_L(0); PG8_MMA(0, 0, At, B0); PG8_BAR; PG8_SCHED;
            PG8_LDB(B1, 0, 1); PG8_STAGE(PG8_SB(0, 0), b2, voffB);
            PG8_BAR; PG8_WAIT_L(0); PG8_MMA(0, 1, At, B1); PG8_BAR;
            PG8_LDA(At, 0, 1); PG8_STAGE(PG8_SA(0, 0), a2, voffA);
            PG8_BAR; PG8_WAIT_L(0); PG8_MMA(1, 0, At, B0); PG8_BAR; PG8_SCHED;
            PG8_STAGE(PG8_SB(0, 1), b2 + hstep, voffB);
            PG8_WAIT_V(6); PG8_BAR; PG8_MMA(1, 1, At, B1); PG8_BAR;
            PG8_LDB(B0, 1, 0); PG8_SCHED; PG8_LDA(At, 1, 0); PG8_STAGE(PG8_SA(0, 1), a2 + hstep, voffA);
            PG8_WAIT_L(8); PG8_BAR; PG8_WAIT_L(0); PG8_MMA(0, 0, At, B0); PG8_BAR; PG8_SCHED;
            PG8_LDB(B1, 1, 1); PG8_STAGE(PG8_SB(1, 0), b3, voffB);
            PG8_BAR; PG8_WAIT_L(0); PG8_MMA(0, 1, At, B1); PG8_BAR;
            PG8_LDA(At, 1, 1); PG8_STAGE(PG8_SA(1, 0), a3, voffA);
            PG8_BAR; PG8_WAIT_L(0); PG8_MMA(1, 0, At, B0); PG8_BAR; PG8_SCHED;
            PG8_STAGE(PG8_SB(1, 1), b3 + hstep, voffB);
            PG8_WAIT_V(6); PG8_BAR; PG8_MMA(1, 1, At, B1); PG8_BAR;
        }
        PG8_STAMP();
        if constexpr (!Epi::AFTER_DRAIN) { E(acc, cur, wr, wc, fr, fq); S.done(cur); }
        PG8_STAMP();
        if (!has_next) break;
#pragma unroll
        for (int a = 0; a < 2; ++a)
#pragma unroll
            for (int b = 0; b < 2; ++b)
#pragma unroll
                for (int m = 0; m < 4; ++m)
#pragma unroll
                    for (int n = 0; n < 2; ++n) acc[a][b][m][n] = (f32x4){0.f, 0.f, 0.f, 0.f};
        cur = nxt; cA = nA; cB = nB; ++ui;
    }
    PG8_WAIT_V(0);
    if (wr == 0) PG8_BAR;
    PG8_BAR;
    if constexpr (Epi::AFTER_DRAIN) { E.fused(acc, cur, wr, wc, fr, fq, lds, wid, lane); S.done(cur); }
    PG8_STAMP();
    if (STAMP && wid == 0) { stamps[lane] = lane < nts ? (((unsigned long long)(unsigned)ts_hi << 32) | (unsigned)ts_lo) : 0ull;
        if (lane == 62) stamps[62] = rt_entry; if (lane == 63) stamps[63] = (unsigned long long)wall_clock64(); }
#undef PG8_STAMP
#undef PG8_SA
#undef PG8_SB
#undef PG8_STAGE
#undef PG8_LDA
#undef PG8_LDB
#undef PG8_MMA
#undef PG8_WAIT_V
#undef PG8_WAIT_L
#undef PG8_BAR
#undef PG8_SCHED
}
}

using pg8::bf16_t; using pg8::bf16x8; using pg8::f32x4; using pg8::u32x4; using pg8::Unit; using pg8::cvt_pk_bf16;
typedef short s16x4 __attribute__((ext_vector_type(4)));
typedef float f32x16 __attribute__((ext_vector_type(16)));
typedef unsigned long long u64;
constexpr int S_ = 16384, DM = 2048, DFF = 5632;
constexpr float EPS_ = 1e-6f;
constexpr size_t MiB = (size_t)1 << 20;
constexpr size_t WS_WIN = 0, WS_WUQ = 32 * MiB, WS_WUKV = WS_WUQ + 3 * MiB / 2, WS_WBR = WS_WUKV + MiB, WS_WOUT = WS_WBR + 8 * MiB, WS_WGU = WS_WOUT + 8 * MiB,
                 WS_WDN = WS_WGU + 44 * MiB, WS_CSA = WS_WDN + 22 * MiB, WS_CSB = WS_CSA + 2 * MiB, WS_SEL = WS_CSB + 4 * MiB, WS_KMS = WS_SEL + MiB,
                 WS_SSQ = WS_KMS + MiB / 4, WS_CTL = WS_SSQ + MiB / 4, WS_BAR = WS_CTL + 65536, WS_ACT = 128 * MiB, WS_END = 512 * MiB;
static_assert(WS_BAR + 4096 <= WS_ACT, "ws map");
constexpr size_t A_XN = 0, A_QA = 64 * MiB, A_KA = 96 * MiB, A_VA = 128 * MiB, A_CQ = 160 * MiB, A_CKV = 176 * MiB, A_KRP = 184 * MiB,
                 A_QN = 0, A_KN = 32 * MiB, A_VB = 192 * MiB, A_QRP = 224 * MiB, A_Y = 240 * MiB, A_T = 0, A_MIX = 128 * MiB,
                 A_HF = 256 * MiB, A_HB = 0, A_ACTV = 64 * MiB,
                 A_P0 = 304 * MiB, A_P1 = 336 * MiB, A_ML = 368 * MiB, A_LIST = 372 * MiB;

struct Params {
    const float* x; const int* pos; const float* attn_norm; const float* w_in; const float* q_norm; const float* w_uq; const float* kv_norm; const float* w_ukv;
    const float* w_ba; const float* w_bb; const float* w_out; const float* ffn_norm; const float* w_gate; const float* w_up; const float* w_down; const float* final_norm;
    float* out; unsigned char* ws;
    float invf_a[16]; float invf_b[32];
    int ph_lo, ph_hi;
};

__device__ __forceinline__ float bflo(unsigned u) { return __uint_as_float(u << 16); }
__device__ __forceinline__ float bfhi(unsigned u) { return __uint_as_float(u & 0xffff0000u); }
__device__ __forceinline__ void st8(bf16_t* p, f32x4 a, f32x4 b) {
    u32x4 w; w.x = cvt_pk_bf16(a[0], a[1]); w.y = cvt_pk_bf16(a[2], a[3]); w.z = cvt_pk_bf16(b[0], b[1]); w.w = cvt_pk_bf16(b[2], b[3]); *(u32x4*)p = w; }
__device__ __forceinline__ void rot4(f32x4& v, const f32x4 t) {
    const float a0 = v[0] * t[0] - v[1] * t[1], a1 = v[1] * t[0] + v[0] * t[1], b0 = v[2] * t[2] - v[3] * t[3], b1 = v[3] * t[2] + v[2] * t[3];
    v[0] = a0; v[1] = a1; v[2] = b0; v[3] = b1; }
__device__ __forceinline__ float sigm(float x) { return __builtin_amdgcn_rcpf(1.0f + __builtin_amdgcn_exp2f(x * -1.4426950408889634f)); }
__device__ __forceinline__ float sq4(const f32x4 v) { return (v[0] * v[0] + v[1] * v[1]) + (v[2] * v[2] + v[3] * v[3]); }
__device__ __forceinline__ float rstd_of(float ssq, float inv_n) { return __builtin_amdgcn_rsqf(ssq * inv_n + EPS_); }

struct EpiProj {
    static constexpr bool PERM = true, AFTER_DRAIN = false;
    bf16_t *qa, *ka, *va, *cq, *ckv, *krp, *gates; const float* csa; const float* csb; float *kms, *ssq_q, *ssq_kv;
    __device__ __forceinline__ void operator()(const f32x4 (&acc)[2][2][4][2], const Unit& u, int wr, int wc, int fr, int fq) const {
        const int pn = u.pn, row0 = u.pm * 256 + wr * 64 + fr, cl = wc * 32 + 8 * fq;
        if (pn < 8) {
            bf16_t* dst = pn < 4 ? qa : ka; const bool isk = pn >= 4; const int hb = (pn & 3) * 256;
            float ks[2][8];
#pragma unroll
            for (int b = 0; b < 2; ++b)
#pragma unroll
                for (int i = 0; i < 8; ++i) ks[b][i] = 0.f;
#pragma unroll
            for (int ai = 0; ai < 2; ++ai)
#pragma unroll
            for (int mh = 0; mh < 2; ++mh) {
                f32x4 tt0[4], tt1[4];
#pragma unroll
                for (int m = 2 * mh; m < 2 * mh + 2; ++m) { tt0[m] = (f32x4){1.f, 0.f, 1.f, 0.f}; tt1[m] = tt0[m];
                    if (wc == 0) { const f32x4* tp = (const f32x4*)(csa + (size_t)(row0 + ai * 128 + m * 16) * 32 + 8 * fq); tt0[m] = tp[0]; tt1[m] = tp[1]; } }
#pragma unroll
                for (int m = 2 * mh; m < 2 * mh + 2; ++m) { const int row = row0 + ai * 128 + m * 16; const f32x4 t0 = tt0[m], t1 = tt1[m];
#pragma unroll
                    for (int bj = 0; bj < 2; ++bj) { f32x4 v0 = acc[ai][bj][m][0], v1 = acc[ai][bj][m][1];
                        if (wc == 0) { rot4(v0, t0); rot4(v1, t1); }
                        if (isk) {
#pragma unroll
                            for (int i = 0; i < 4; ++i) { ks[bj][i] += v0[i]; ks[bj][4 + i] += v1[i]; } }
                        st8(dst + (size_t)row * 1024 + hb + bj * 128 + cl, v0, v1); } } }
            if (isk) {
#pragma unroll
                for (int bj = 0; bj < 2; ++bj)
#pragma unroll
                    for (int i = 0; i < 8; ++i) { float s = ks[bj][i]; s += __shfl_xor(s, 1); s += __shfl_xor(s, 2); s += __shfl_xor(s, 4); s += __shfl_xor(s, 8);
                        if (fr == 0) atomicAdd(kms + ((size_t)((pn & 3) * 2 + bj) * 64 + u.pm) * 128 + cl + i, s); } }
        } else if (pn < 12) {
#pragma unroll
            for (int ai = 0; ai < 2; ++ai)
#pragma unroll
                for (int m = 0; m < 4; ++m) { const int row = row0 + ai * 128 + m * 16;
#pragma unroll
                    for (int bj = 0; bj < 2; ++bj) st8(va + (size_t)row * 1024 + (pn - 8) * 256 + bj * 128 + cl, acc[ai][bj][m][0], acc[ai][bj][m][1]); }
        } else if (pn < 15) {
            const bool isq = pn < 14; bf16_t* dst = isq ? cq : ckv; const int ld = isq ? 512 : 256, cb = isq ? (pn - 12) * 256 : 0; float* ssq = isq ? ssq_q : ssq_kv;
#pragma unroll
            for (int ai = 0; ai < 2; ++ai)
#pragma unroll
                for (int m = 0; m < 4; ++m) { const int row = row0 + ai * 128 + m * 16; float s = 0.f;
#pragma unroll
                    for (int bj = 0; bj < 2; ++bj) { s += sq4(acc[ai][bj][m][0]) + sq4(acc[ai][bj][m][1]); st8(dst + (size_t)row * ld + cb + bj * 128 + cl, acc[ai][bj][m][0], acc[ai][bj][m][1]); }
                    s += __shfl_xor(s, 16); s += __shfl_xor(s, 32);
                    if (fq == 0) atomicAdd(ssq + row, s); }
        } else if (pn == 15) {
            if (wc < 2) {
#pragma unroll
                for (int ai = 0; ai < 2; ++ai)
#pragma unroll
                for (int mh = 0; mh < 2; ++mh) { f32x4 tt0[4], tt1[4];
#pragma unroll
                    for (int m = 2 * mh; m < 2 * mh + 2; ++m) { const f32x4* tp = (const f32x4*)(csb + (size_t)(row0 + ai * 128 + m * 16) * 64 + 32 * wc + 8 * fq); tt0[m] = tp[0]; tt1[m] = tp[1]; }
#pragma unroll
                    for (int m = 2 * mh; m < 2 * mh + 2; ++m) { const int row = row0 + ai * 128 + m * 16; f32x4 v0 = acc[ai][0][m][0], v1 = acc[ai][0][m][1];
                        rot4(v0, tt0[m]); rot4(v1, tt1[m]); st8(krp + (size_t)row * 64 + cl, v0, v1); } } }
        } else {
#pragma unroll
            for (int ai = 0; ai < 2; ++ai)
#pragma unroll
                for (int m = 0; m < 4; ++m) { const int row = row0 + ai * 128 + m * 16;
#pragma unroll
                    for (int bj = 0; bj < 2; ++bj) { f32x4 v0 = acc[ai][bj][m][0], v1 = acc[ai][bj][m][1];
#pragma unroll
                        for (int i = 0; i < 4; ++i) { v0[i] = sigm(v0[i]); v1[i] = sigm(v1[i]); }
                        st8(gates + (size_t)row * 4096 + (pn - 16) * 256 + bj * 128 + cl, v0, v1); } }
        }
    }
};
struct EpiQ {
    static constexpr bool PERM = true, AFTER_DRAIN = false;
    bf16_t *qn, *qrp; const float* csb; const float* ssq_q;
    __device__ __forceinline__ void operator()(const f32x4 (&acc)[2][2][4][2], const Unit& u, int wr, int wc, int fr, int fq) const {
        const int pn = u.pn, row0 = u.pm * 256 + wr * 64 + fr, cl = wc * 32 + 8 * fq;
        float sq[2][4];
#pragma unroll
        for (int ai = 0; ai < 2; ++ai)
#pragma unroll
            for (int m = 0; m < 4; ++m) sq[ai][m] = ssq_q[row0 + ai * 128 + m * 16];
#pragma unroll
        for (int ai = 0; ai < 2; ++ai)
#pragma unroll
        for (int mh = 0; mh < 2; ++mh) { f32x4 tt0[4], tt1[4];
#pragma unroll
            for (int m = 2 * mh; m < 2 * mh + 2; ++m) if (pn >= 4) { const f32x4* tp = (const f32x4*)(csb + (size_t)(row0 + ai * 128 + m * 16) * 64 + 32 * (wc & 1) + 8 * fq); tt0[m] = tp[0]; tt1[m] = tp[1]; }
#pragma unroll
            for (int m = 2 * mh; m < 2 * mh + 2; ++m) { const int row = row0 + ai * 128 + m * 16; const float r = rstd_of(sq[ai][m], 1.0f / 512.0f);
                if (pn < 4) {
#pragma unroll
                    for (int bj = 0; bj < 2; ++bj) st8(qn + (size_t)row * 1024 + pn * 256 + bj * 128 + cl, acc[ai][bj][m][0] * r, acc[ai][bj][m][1] * r);
                } else { const f32x4 t0 = tt0[m], t1 = tt1[m];
#pragma unroll
                    for (int bj = 0; bj < 2; ++bj) { f32x4 v0 = acc[ai][bj][m][0] * r, v1 = acc[ai][bj][m][1] * r; rot4(v0, t0); rot4(v1, t1);
                        st8(qrp + (size_t)row * 512 + (pn - 4) * 256 + bj * 128 + cl, v0, v1); } } } }
    }
};
struct EpiKV {
    static constexpr bool PERM = true, AFTER_DRAIN = false;
    bf16_t *kn, *vb; const float* ssq_kv;
    __device__ __forceinline__ void operator()(const f32x4 (&acc)[2][2][4][2], const Unit& u, int wr, int wc, int fr, int fq) const {
        const int pn = u.pn, row0 = u.pm * 256 + wr * 64 + fr, cl = wc * 32 + 8 * fq;
        float sq[2][4];
#pragma unroll
        for (int ai = 0; ai < 2; ++ai)
#pragma unroll
            for (int m = 0; m < 4; ++m) sq[ai][m] = ssq_kv[row0 + ai * 128 + m * 16];
#pragma unroll
        for (int ai = 0; ai < 2; ++ai)
#pragma unroll
            for (int m = 0; m < 4; ++m) { const int row = row0 + ai * 128 + m * 16; const float r = rstd_of(sq[ai][m], 1.0f / 256.0f);
                st8(kn + (size_t)row * 1024 + pn * 128 + cl, acc[ai][0][m][0] * r, acc[ai][0][m][1] * r);
                st8(vb + (size_t)row * 1024 + pn * 128 + cl, acc[ai][1][m][0] * r, acc[ai][1][m][1] * r);
                asm volatile("" ::: "memory"); }
    }
};
struct EpiBranch {
    static constexpr bool PERM = true, AFTER_DRAIN = false;
    const bf16_t* gates; bf16_t* T; bf16_t* mixed;
    __device__ __forceinline__ void operator()(const f32x4 (&acc)[2][2][4][2], const Unit& u, int wr, int wc, int fr, int fq) const {
        const bool isb = u.pm >= 64; const int pm = isb ? u.pm - 64 : u.pm, pn = isb ? u.pn - 8 : u.pn;
        const int row0 = pm * 256 + wr * 64 + fr, cl = wc * 32 + 8 * fq;
#pragma unroll
        for (int ai = 0; ai < 2; ++ai) {
            u32x4 gwv[4][2], tvv[4][2];
#pragma unroll
            for (int m = 0; m < 4; ++m)
#pragma unroll
                for (int bj = 0; bj < 2; ++bj) { const int row = row0 + ai * 128 + m * 16, col = pn * 256 + bj * 128 + cl;
                    gwv[m][bj] = *(const u32x4*)(gates + (size_t)row * 4096 + (isb ? 2048 : 0) + col);
                    if (isb) tvv[m][bj] = *(const u32x4*)(T + (size_t)row * 2048 + col); }
#pragma unroll
            for (int m = 0; m < 4; ++m) { const int row = row0 + ai * 128 + m * 16;
#pragma unroll
                for (int bj = 0; bj < 2; ++bj) { const int col = pn * 256 + bj * 128 + cl;
                    const u32x4 gw = gwv[m][bj];
                    const f32x4 g0 = {bflo(gw.x), bfhi(gw.x), bflo(gw.y), bfhi(gw.y)}, g1 = {bflo(gw.z), bfhi(gw.z), bflo(gw.w), bfhi(gw.w)};
                    if (!isb) st8(T + (size_t)row * 2048 + col, g0 * acc[ai][bj][m][0], g1 * acc[ai][bj][m][1]);
                    else { const u32x4 tw = tvv[m][bj];
                        const f32x4 a0 = {bflo(tw.x), bfhi(tw.x), bflo(tw.y), bfhi(tw.y)}, a1 = {bflo(tw.z), bfhi(tw.z), bflo(tw.w), bfhi(tw.w)};
                        st8(mixed + (size_t)row * 2048 + col, a0 + g0 * acc[ai][bj][m][0], a1 + g1 * acc[ai][bj][m][1]); } } } }
    }
};
struct BranchOrder {
    pg8::StaticOrder so;
    __device__ void init(int G, int c) { so.init(S_, DM, G, c); }
    __device__ bool next(int i, Unit& u) const { if (!so.next(i >> 1, u)) return false; if (i & 1) { u.pm += 64; u.pn += 8; } return true; }
    __device__ __forceinline__ void a_ready(const Unit&) const {}
    __device__ __forceinline__ void done(const Unit&) const {}
};
struct EpiOut {
    static constexpr bool PERM = true, AFTER_DRAIN = false;
    const float* x; float* hf; bf16_t* hb; float* ssq_h;
    __device__ __forceinline__ void operator()(const f32x4 (&acc)[2][2][4][2], const Unit& u, int wr, int wc, int fr, int fq) const {
        const int pn = u.pn, row0 = u.pm * 256 + wr * 64 + fr, cl = wc * 32 + 8 * fq;
#pragma unroll
        for (int ai = 0; ai < 2; ++ai) {
            f32x4 xv0[4][2], xv1[4][2];
#pragma unroll
            for (int m = 0; m < 4; ++m)
#pragma unroll
                for (int bj = 0; bj < 2; ++bj) { const size_t o = (size_t)(row0 + ai * 128 + m * 16) * 2048 + pn * 256 + bj * 128 + cl; xv0[m][bj] = *(const f32x4*)(x + o); xv1[m][bj] = *(const f32x4*)(x + o + 4); }
#pragma unroll
            for (int m = 0; m < 4; ++m) { const int row = row0 + ai * 128 + m * 16; float s = 0.f;
#pragma unroll
                for (int bj = 0; bj < 2; ++bj) { const size_t o = (size_t)row * 2048 + pn * 256 + bj * 128 + cl;
                    const f32x4 h0 = xv0[m][bj] + acc[ai][bj][m][0], h1 = xv1[m][bj] + acc[ai][bj][m][1];
                    *(f32x4*)(hf + o) = h0; *(f32x4*)(hf + o + 4) = h1; st8(hb + o, h0, h1); s += sq4(h0) + sq4(h1); }
                s += __shfl_xor(s, 16); s += __shfl_xor(s, 32);
                if (fq == 0) atomicAdd(ssq_h + row, s); } }
    }
};
struct EpiGU {
    static constexpr bool PERM = true, AFTER_DRAIN = false;
    bf16_t* act; const float* ssq_h;
    __device__ __forceinline__ void operator()(const f32x4 (&acc)[2][2][4][2], const Unit& u, int wr, int wc, int fr, int fq) const {
        const int pn = u.pn, row0 = u.pm * 256 + wr * 64 + fr, cl = wc * 32 + 8 * fq;
        float sq[2][4];
#pragma unroll
        for (int ai = 0; ai < 2; ++ai)
#pragma unroll
            for (int m = 0; m < 4; ++m) sq[ai][m] = ssq_h[row0 + ai * 128 + m * 16];
#pragma unroll
        for (int ai = 0; ai < 2; ++ai)
#pragma unroll
            for (int m = 0; m < 4; ++m) { const int row = row0 + ai * 128 + m * 16; const float r = rstd_of(sq[ai][m], 1.0f / 2048.0f);
                f32x4 o0, o1;
#pragma unroll
                for (int i = 0; i < 4; ++i) { const float g0 = acc[ai][0][m][0][i] * r, g1 = acc[ai][0][m][1][i] * r;
                    o0[i] = g0 * sigm(g0) * (acc[ai][1][m][0][i] * r); o1[i] = g1 * sigm(g1) * (acc[ai][1][m][1][i] * r); }
                st8(act + (size_t)row * DFF + pn * 128 + cl, o0, o1); }
    }
};
struct EpiDown {
    static constexpr bool PERM = true, AFTER_DRAIN = false;
    const float* hf; float* out; float* ssq_o;
    __device__ __forceinline__ void operator()(const f32x4 (&acc)[2][2][4][2], const Unit& u, int wr, int wc, int fr, int fq) const {
        const int pn = u.pn, row0 = u.pm * 256 + wr * 64 + fr, cl = wc * 32 + 8 * fq;
#pragma unroll
        for (int ai = 0; ai < 2; ++ai) {
            f32x4 xv0[4][2], xv1[4][2];
#pragma unroll
            for (int m = 0; m < 4; ++m)
#pragma unroll
                for (int bj = 0; bj < 2; ++bj) { const size_t o = (size_t)(row0 + ai * 128 + m * 16) * 2048 + pn * 256 + bj * 128 + cl; xv0[m][bj] = *(const f32x4*)(hf + o); xv1[m][bj] = *(const f32x4*)(hf + o + 4); }
#pragma unroll
            for (int m = 0; m < 4; ++m) { const int row = row0 + ai * 128 + m * 16; float s = 0.f;
#pragma unroll
                for (int bj = 0; bj < 2; ++bj) { const size_t o = (size_t)row * 2048 + pn * 256 + bj * 128 + cl;
                    const f32x4 h0 = xv0[m][bj] + acc[ai][bj][m][0], h1 = xv1[m][bj] + acc[ai][bj][m][1];
                    *(f32x4*)(out + o) = h0; *(f32x4*)(out + o + 4) = h1; s += sq4(h0) + sq4(h1); }
                s += __shfl_xor(s, 16); s += __shfl_xor(s, 32);
                if (fq == 0) atomicAdd(ssq_o + row, s); } }
    }
};

namespace att {
constexpr int SHM_V = 16384, SHM_K = 16384, SHM_K2 = 64 * 144;
constexpr int OFF_K = 0, OFF_K2 = 2 * SHM_K, OFF_V = OFF_K2 + 2 * SHM_K2, OFF_WS = OFF_V + 2 * SHM_V, OFF_MISC = OFF_WS + 8 * 64 * 4, OFF_Q2 = OFF_MISC + 1024;
#define KSWZ(row, colB) ((row) * 256 + ((colB) ^ (((row) & 7) << 4)))
#define K2SWZ(row, colB) ((row) * 144 + (colB))
#define SBAR() __builtin_amdgcn_sched_barrier(0)
__device__ __forceinline__ int v_st(int k, int c) { const int kk = (k & ~0xC) | ((k & 4) << 1) | ((k & 8) >> 1); return ((kk >> 3) * 4 + (c >> 5)) * 512 + ((kk & 7) * 32 + (c & 31)) * 2; }
__device__ __forceinline__ int v_rd_base(int lane) { return ((lane & 3) << 3) | (((lane >> 2) & 3) << 6) | (((lane >> 4) & 1) << 5) | (((lane >> 5) & 1) << 8); }
constexpr int v_rd_off(int d0, int ks, int half) { return d0 * 512 + ks * 4096 + half * 2048; }
__device__ __forceinline__ int crow(int r, int hi) { return (r & 3) + 8 * (r >> 2) + 4 * hi; }
__device__ __forceinline__ unsigned cvtpk(float lo, float hi) { return pg8::cvt_pk_bf16(lo, hi); }
__device__ __forceinline__ void mask_tile(f32x16& p0, f32x16& p1, int dq) {
    const float NEG = -__builtin_inff();
#pragma unroll
    for (int r = 0; r < 16; ++r) { const int c = (r & 3) + 8 * (r >> 2);
        if (dq - c < 0) p0[r] = NEG;
        if (dq - c - 32 < 0) p1[r] = NEG; }
}
__device__ __forceinline__ void partialSM(f32x16& p0, f32x16& p1, float& m_reg, float& mn, float& alpha, const float C2) {
    float pmax = p0[0];
#pragma unroll
    for (int r = 1; r < 16; ++r) pmax = fmaxf(pmax, p0[r]);
#pragma unroll
    for (int r = 0; r < 16; ++r) pmax = fmaxf(pmax, p1[r]);
    { auto rr = __builtin_amdgcn_permlane32_swap(__float_as_uint(pmax), __float_as_uint(pmax), false, false);
      pmax = fmaxf(__uint_as_float(rr[0]), __uint_as_float(rr[1])); }
    if (__builtin_expect(__all((pmax - m_reg) * C2 <= 11.5f), 1)) { mn = m_reg; alpha = 1.f; }
    else { mn = fmaxf(m_reg, pmax); alpha = __builtin_amdgcn_exp2f((m_reg - mn) * C2); m_reg = mn; }
    const float mnL = -mn * C2;
#pragma unroll
    for (int r = 0; r < 16; ++r) p0[r] = fmaf(p0[r], C2, mnL);
#pragma unroll
    for (int r = 0; r < 16; ++r) p1[r] = fmaf(p1[r], C2, mnL);
#pragma unroll
    for (int r = 0; r < 16; ++r) p0[r] = __builtin_amdgcn_exp2f(p0[r]);
}
__device__ __forceinline__ void finishSM(f32x16& p0, f32x16& p1, float alpha, float& l_reg, bf16x8& pa0, bf16x8& pa1, bf16x8& pa2, bf16x8& pa3) {
#pragma unroll
    for (int r = 0; r < 16; ++r) p1[r] = __builtin_amdgcn_exp2f(p1[r]);
    float ps = 0;
#pragma unroll
    for (int r = 0; r < 16; ++r) ps += p0[r];
#pragma unroll
    for (int r = 0; r < 16; ++r) ps += p1[r];
    { auto rr = __builtin_amdgcn_permlane32_swap(__float_as_uint(ps), __float_as_uint(ps), false, false);
      ps = __uint_as_float(rr[0]) + __uint_as_float(rr[1]); }
    l_reg = l_reg * alpha + ps;
#define PK4(P, B_, OUT) do { unsigned a0 = cvtpk(P[B_+0], P[B_+1]), a1 = cvtpk(P[B_+2], P[B_+3]);                          \
        unsigned b0 = cvtpk(P[B_+4], P[B_+5]), b1 = cvtpk(P[B_+6], P[B_+7]);                                             \
        auto r0 = __builtin_amdgcn_permlane32_swap(a0, b0, false, false); auto r1 = __builtin_amdgcn_permlane32_swap(a1, b1, false, false); \
        u32x4 w = {r0[0], r1[0], r0[1], r1[1]}; OUT = *reinterpret_cast<bf16x8*>(&w); } while (0)
    PK4(p0, 0, pa0); PK4(p0, 8, pa1); PK4(p1, 0, pa2); PK4(p1, 8, pa3);
#undef PK4
}
__device__ __forceinline__ bf16x8 pack8v(const f32x16& p, int b) { u32x4 w = {cvtpk(p[b], p[b + 1]), cvtpk(p[b + 2], p[b + 3]), cvtpk(p[b + 4], p[b + 5]), cvtpk(p[b + 6], p[b + 7])}; return *reinterpret_cast<bf16x8*>(&w); }
template <int KB, bool MLA>
__device__ __forceinline__ void qkt(f32x16& p0, f32x16& p1, const char* lds, int r32, int hi, const bf16x8* qr, const char* q2p) {
    p0 = f32x16{}; p1 = f32x16{};
    const char* kb[4];
#pragma unroll
    for (int dd = 0; dd < 4; ++dd) kb[dd] = lds + OFF_K + KB * SHM_K + KSWZ(r32, (dd * 16 + hi * 8) * 2);
#pragma unroll
    for (int d0 = 0; d0 < 8; ++d0) { const char* a = kb[d0 & 3] + (d0 >> 2) * 128;
        bf16x8 b0 = *reinterpret_cast<const bf16x8*>(a);
        bf16x8 b1 = *reinterpret_cast<const bf16x8*>(a + 32 * 256);
        p0 = __builtin_amdgcn_mfma_f32_32x32x16_bf16(b0, qr[d0], p0, 0, 0, 0);
        p1 = __builtin_amdgcn_mfma_f32_32x32x16_bf16(b1, qr[d0], p1, 0, 0, 0); }
    if constexpr (MLA) {
#pragma unroll
        for (int d0 = 0; d0 < 4; ++d0) { const char* a = lds + OFF_K2 + KB * SHM_K2 + K2SWZ(r32, (d0 * 16 + hi * 8) * 2);
            bf16x8 b0 = *reinterpret_cast<const bf16x8*>(a);
            bf16x8 b1 = *reinterpret_cast<const bf16x8*>(a + 32 * 144);
            const bf16x8 qf = *reinterpret_cast<const bf16x8*>(q2p + d0 * 1024);
            p0 = __builtin_amdgcn_mfma_f32_32x32x16_bf16(b0, qf, p0, 0, 0, 0);
            p1 = __builtin_amdgcn_mfma_f32_32x32x16_bf16(b1, qf, p1, 0, 0, 0); }
    }
    constexpr int NR = MLA ? 28 : 16, NM = MLA ? 24 : 16, AHEAD = 8;
    __builtin_amdgcn_sched_group_barrier(0x100, AHEAD, 0);
#pragma unroll
    for (int i = 0; i < NR - AHEAD; ++i) { __builtin_amdgcn_sched_group_barrier(0x008, 1, 0); __builtin_amdgcn_sched_group_barrier(0x100, 1, 0); }
    __builtin_amdgcn_sched_group_barrier(0x008, NM - (NR - AHEAD), 0);
}
typedef s16x4 __attribute__((address_space(3)))* lds_s16x4_p;
template <int VB>
__device__ __forceinline__ void pv_tile(f32x16* o, const __attribute__((address_space(3))) char* vbp, bf16x8 pa0, bf16x8 pa1, bf16x8 pa2, bf16x8 pa3) {
#define TRRD(off) __builtin_amdgcn_ds_read_tr16_b64_v4i16((lds_s16x4_p)(vbp + (off)))
#define PV_D0(d0) do { constexpr int b_ = VB * SHM_V + v_rd_off(d0, 0, 0);                                                                   \
        const s16x4 l0 = TRRD(b_), h0 = TRRD(b_ + 2048), l1 = TRRD(b_ + 4096), h1 = TRRD(b_ + 6144), l2 = TRRD(b_ + 8192), h2 = TRRD(b_ + 10240), l3 = TRRD(b_ + 12288), h3 = TRRD(b_ + 14336); \
        o[d0] = __builtin_amdgcn_mfma_f32_32x32x16_bf16(pa0, (bf16x8){l0[0], l0[1], l0[2], l0[3], h0[0], h0[1], h0[2], h0[3]}, o[d0], 0, 0, 0);   \
        o[d0] = __builtin_amdgcn_mfma_f32_32x32x16_bf16(pa1, (bf16x8){l1[0], l1[1], l1[2], l1[3], h1[0], h1[1], h1[2], h1[3]}, o[d0], 0, 0, 0);   \
        o[d0] = __builtin_amdgcn_mfma_f32_32x32x16_bf16(pa2, (bf16x8){l2[0], l2[1], l2[2], l2[3], h2[0], h2[1], h2[2], h2[3]}, o[d0], 0, 0, 0);   \
        o[d0] = __builtin_amdgcn_mfma_f32_32x32x16_bf16(pa3, (bf16x8){l3[0], l3[1], l3[2], l3[3], h3[0], h3[1], h3[2], h3[3]}, o[d0], 0, 0, 0); } while (0)
    PV_D0(0); PV_D0(1); PV_D0(2); PV_D0(3);
#undef PV_D0
#undef TRRD
}

struct AttnIO { const bf16_t* Q; const bf16_t* Q2; const bf16_t* K; const bf16_t* K2; const bf16_t* V; bf16_t* O; long long d2; float2* ml; const unsigned short* list; };

template <int MODE, int VAR = 0>
__device__ __forceinline__ void attn_item(char* lds, const AttnIO& io, int h, int qb, int cbase, int nvalid, float C2) {
    constexpr bool MLA = (MODE == 0);
    int tid_ = threadIdx.x; asm volatile("" : "+v"(tid_));
    const int tid = tid_, wid = __builtin_amdgcn_readfirstlane(tid >> 6), lane = tid & 63, r32 = lane & 31, hi = lane >> 5;
    const int q0 = qb * 256, qlo = q0 + wid * 32;
    int row = qlo + r32, ent = 0; bool valid = true;
    if constexpr (MODE == 2) { const int e = wid * 32 + r32; valid = e < nvalid; ent = (int)io.list[(size_t)cbase + (valid ? e : 0)]; row = ent & 0x3fff; }
    const int qm = row - 4 * hi;
    float* wsf = (float*)(lds + OFF_WS) + wid * 64; float* li_l = wsf; float* al_l = wsf + 32;
    bf16x8 qr[8]; const char* q2p = lds + OFF_Q2 + wid * 4096 + lane * 16;
#pragma unroll
    for (int d0 = 0; d0 < 8; ++d0) qr[d0] = *(const bf16x8*)(io.Q + (size_t)row * 1024 + h * 128 + d0 * 16 + hi * 8);
    if constexpr (MLA) {
#pragma unroll
        for (int d0 = 0; d0 < 4; ++d0) *(bf16x8*)(lds + OFF_Q2 + wid * 4096 + d0 * 1024 + lane * 16) = *(const bf16x8*)(io.Q2 + (size_t)row * 512 + h * 64 + d0 * 16 + hi * 8);
    }
    const int NT = MLA ? 4 * (qb + 1) : 4, kb0 = MLA ? 0 : q0;
    const int sr = tid >> 4, sc = (tid & 15) * 8, vst0 = v_st(sr, sc), vst1 = v_st(32 + sr, sc), kws = KSWZ(sr, sc * 2);
    const int s2r = tid >> 3, s2c = (tid & 7) * 8, k2ws = K2SWZ(s2r, s2c * 2);
    const __attribute__((address_space(3))) char* vbp = (const __attribute__((address_space(3))) char*)(unsigned)((int)(uintptr_t)(lds) + OFF_V + v_rd_base(lane));
    const bf16_t* Kh = io.K + h * 128 + sc; const bf16_t* Vh = io.V + h * 128 + sc; const bf16_t* K2h = MLA ? io.K2 + s2c : nullptr;
    float m_reg = -1e30f, l_reg = 0.f; f32x16 o[4] = {};
#define KEY0(t) (kb0 + (t) * 64)
#define LOADS_K(kk_) do { st_k0 = *(const bf16x8*)(Kh + (size_t)((kk_) + sr) * 1024); st_k1 = *(const bf16x8*)(Kh + (size_t)((kk_) + 32 + sr) * 1024);      \
                       if constexpr (MLA) st_k2 = *(const bf16x8*)(K2h + (size_t)((kk_) + s2r) * 64); } while (0)
#define LOADS_V(kk_) do { st_v0 = *(const bf16x8*)(Vh + (size_t)((kk_) + sr) * 1024); st_v1 = *(const bf16x8*)(Vh + (size_t)((kk_) + 32 + sr) * 1024); } while (0)
#define WRITES_K(bf) do { *(bf16x8*)(lds + OFF_K + (bf) * SHM_K + kws) = st_k0; *(bf16x8*)(lds + OFF_K + (bf) * SHM_K + kws + 32 * 256) = st_k1;           \
                        if constexpr (MLA) *(bf16x8*)(lds + OFF_K2 + (bf) * SHM_K2 + k2ws) = st_k2; } while (0)
#define WRITES_V(bf) do { *(bf16x8*)(lds + OFF_V + (bf) * SHM_V + vst0) = st_v0; *(bf16x8*)(lds + OFF_V + (bf) * SHM_V + vst1) = st_v1; } while (0)
#define RESC(a) do { if (__any((a) < 1.f)) { if (hi == 0) al_l[r32] = (a); asm volatile("s_waitcnt lgkmcnt(0)" ::: "memory");              \
                     for (int d_ = 0; d_ < 4; ++d_) for (int r = 0; r < 16; ++r) o[d_][r] *= al_l[crow(r, hi)]; } } while (0)
#define BAR() do { asm volatile("s_waitcnt lgkmcnt(0)" ::: "memory"); __builtin_amdgcn_s_barrier(); asm volatile("" ::: "memory"); } while (0)
    const int grp = wid >> 2;
    f32x16 p0, p1; bf16x8 pa0, pa1, pa2, pa3; float mn, al;
    bf16x8 st_k0, st_k1, st_v0, st_v1, st_k2;
#define ATT_STEP(t_, KB) do { const int t__ = (t_); const int k0__ = KEY0(t__);                                                                       \
        if (grp == 0) { if (t__ + 1 < NT) LOADS_K(KEY0(t__ + 1)); LOADS_V(k0__); } SBAR();                                                           \
        if (t__ > 0) pv_tile<(KB) ^ 1>(o, vbp, pa0, pa1, pa2, pa3); SBAR();                                                                          \
        qkt<KB, MLA>(p0, p1, lds, r32, hi, qr, q2p);                                                                                                 \
        if constexpr (MODE != 2) { if (k0__ + 63 > qlo) mask_tile(p0, p1, qm - k0__); }                                                              \
        SBAR(); if (grp == 1) { if (t__ + 1 < NT) WRITES_K((KB) ^ 1); WRITES_V(KB); }                                                                \
        BAR();                                                                                                                                       \
        if (grp == 1) { if (t__ + 2 < NT) LOADS_K(KEY0(t__ + 2)); if (t__ + 1 < NT) LOADS_V(KEY0(t__ + 1)); } SBAR();                                \
        partialSM(p0, p1, m_reg, mn, al, C2); finishSM(p0, p1, al, l_reg, pa0, pa1, pa2, pa3); RESC(al);                                            \
        SBAR(); if (grp == 0) { if (t__ + 1 < NT) WRITES_K((KB) ^ 1); WRITES_V(KB); }                                                                \
        BAR(); } while (0)
    { const int k00 = KEY0(0); LOADS_K(k00); WRITES_K(0); }
    if (grp == 1) { LOADS_K(KEY0(1)); LOADS_V(KEY0(0)); }
    BAR();
    if (grp == 1) BAR();
    for (int t = 0; t < NT; t += 2) { ATT_STEP(t, 0); ATT_STEP(t + 1, 1); }
    pv_tile<1>(o, vbp, pa0, pa1, pa2, pa3);
    BAR();
    if (grp == 0) BAR();
    int* ri_l = (int*)al_l;
    if (hi == 0) { li_l[r32] = l_reg; if constexpr (MODE == 2) ri_l[r32] = valid ? ent : -1; }
    asm volatile("s_waitcnt lgkmcnt(0)" ::: "memory");
    if constexpr (MODE != 0) { if (hi == 0 && valid) io.ml[((size_t)row * 8 + h) * 4 + (MODE == 1 ? 3 : (ent >> 14))] = make_float2(m_reg * C2, l_reg); }
#pragma unroll
    for (int r = 0; r < 16; ++r) { const int orow = crow(r, hi); const float rl = 1.0f / li_l[orow];
        bf16_t* Ow; bool st = true;
        if constexpr (MODE == 2) { const int info = ri_l[orow]; st = info >= 0; const int sl = info >> 14; Ow = io.O + ((long long)sl * (16384LL * 1024) + (sl == 2 ? io.d2 : 0LL)) + (size_t)(info & 0x3fff) * 1024 + h * 128; }
        else Ow = io.O + (size_t)(qlo + orow) * 1024 + h * 128;
#pragma unroll
        for (int d0 = 0; d0 < 4; ++d0) { const float v = o[d0][r] * rl; const float vn = __shfl_xor(v, 1);
            if ((VAR == 0 || C2 < 0.f) && st && (r32 & 1) == 0) *(unsigned*)(Ow + d0 * 32 + r32) = cvtpk(v, vn); } }
    BAR();
#undef KEY0
#undef LOADS_K
#undef LOADS_V
#undef WRITES_K
#undef WRITES_V
#undef RESC
#undef ATT_STEP
#undef BAR
}
}

struct WJob { const float* s1; const float* s2; const float* gain; bf16_t* dst; int ld, K, map, ntn; };
__device__ __forceinline__ const float* wsrc(int map, const float* s1, const float* s2, int n) {
    if (map == 0) return s1 + n;
    if (map == 1) {
        if (n < 2048) { const int hb = n & ~127, c = n & 127; const int d = c < 32 ? ((c >> 1) + 16 * (c & 1)) : c; return s1 + hb + d; }
        if (n < 3840) return s1 + n;
        if (n < 3904) { const int c = n - 3840; return s1 + 3840 + (c >> 1) + 32 * (c & 1); }
        if (n < 4096) return nullptr;
        return s1 + 3904 + (n - 4096); }
    if (map == 2) {
        if (n < 1024) return s1 + (n >> 7) * 192 + (n & 127);
        const int c = n - 1024, h = c >> 6, cc = c & 63; return s1 + h * 192 + 128 + (cc >> 1) + 32 * (cc & 1); }
    { const int t = n >> 8, r = n & 255; return r < 128 ? s1 + 128 * t + r : s2 + 128 * t + (r - 128); }
}
__device__ __forceinline__ bool wtile_load(const WJob& J, int tn, int tk, int lane, float (&v)[64]) {
    const float* sp = wsrc(J.map, J.s1, J.s2, tn * 64 + lane); const bool has = sp != nullptr; if (!has) sp = J.s1;
    const int k0 = tk * 64;
#pragma unroll
    for (int i = 0; i < 64; ++i) v[i] = __builtin_nontemporal_load(sp + (size_t)(k0 + i) * J.ld);
    return has;
}
__device__ __forceinline__ void wtile_store(const WJob& J, int tn, int tk, int lane, float (&v)[64], bool has) {
    const int k0 = tk * 64;
    if (J.gain) {
#pragma unroll
        for (int i = 0; i < 64; ++i) v[i] *= J.gain[k0 + i]; }
    if (!has) {
#pragma unroll
        for (int i = 0; i < 64; ++i) v[i] = 0.f; }
    bf16_t* d = J.dst + (size_t)(tn * 64 + lane) * J.K + k0;
#pragma unroll
    for (int i = 0; i < 8; ++i) { u32x4 w; w.x = cvt_pk_bf16(v[8 * i], v[8 * i + 1]); w.y = cvt_pk_bf16(v[8 * i + 2], v[8 * i + 3]); w.z = cvt_pk_bf16(v[8 * i + 4], v[8 * i + 5]); w.w = cvt_pk_bf16(v[8 * i + 6], v[8 * i + 7]);
        *(u32x4*)(d + 8 * i) = w; }
}
__device__ __forceinline__ WJob wjob_of(const Params& P, unsigned char* ws, int t, int& lt) {
    if (t < 4096) { lt = t; return WJob{P.w_in, nullptr, nullptr, (bf16_t*)(ws + WS_WIN), 8000, 2048, 1, 128}; }
    if (t < 4288) { lt = t - 4096; return WJob{P.w_uq, nullptr, P.q_norm, (bf16_t*)(ws + WS_WUQ), 1536, 512, 2, 24}; }
    if (t < 4416) { lt = t - 4288; return WJob{P.w_ukv, nullptr, P.kv_norm, (bf16_t*)(ws + WS_WUKV), 2048, 256, 0, 32}; }
    if (t < 4928) { lt = t - 4416; return WJob{P.w_ba, nullptr, nullptr, (bf16_t*)(ws + WS_WBR), 2048, 1024, 0, 32}; }
    if (t < 5440) { lt = t - 4928; return WJob{P.w_bb, nullptr, nullptr, (bf16_t*)(ws + WS_WBR) + (size_t)2048 * 1024, 2048, 1024, 0, 32}; }
    if (t < 6464) { lt = t - 5440; return WJob{P.w_out, nullptr, nullptr, (bf16_t*)(ws + WS_WOUT), 2048, 2048, 0, 32}; }
    if (t < 12096) { lt = t - 6464; return WJob{P.w_gate, P.w_up, P.ffn_norm, (bf16_t*)(ws + WS_WGU), 5632, 2048, 3, 176}; }
    lt = t - 12096; return WJob{P.w_down, nullptr, nullptr, (bf16_t*)(ws + WS_WDN), 2048, 5632, 0, 32};
}
__device__ __forceinline__ void sincos_rev(float ang, float& c, float& s) {
    const double rev = (double)ang * 0.15915494309189535; const float fr = (float)(rev - __builtin_rint(rev));
    c = __builtin_amdgcn_cosf(fr); s = __builtin_amdgcn_sinf(fr); }
__device__ __forceinline__ void phase0(const Params& P, char* lds) {
    const int tid = threadIdx.x, lane = tid & 63, wid = tid >> 6, gtid = blockIdx.x * 512 + tid, gsz = gridDim.x * 512;
    unsigned char* ws = P.ws;
    { float* z = (float*)(ws + WS_KMS); for (int i = gtid; i < 65536 + 65536 + 1024; i += gsz) z[i] = 0.f; }
    { float* csa = (float*)(ws + WS_CSA); float* csb = (float*)(ws + WS_CSB);
#define ROPE_TAB(T_, W_, F_, B_) do { _Pragma("unroll") for (int q_ = 0; q_ < 8; ++q_) { float c_, s_; sincos_rev(pf * F_[(B_) + q_], c_, s_);               \
          T_[(size_t)row * (W_) + 2 * ((B_) + q_)] = c_; T_[(size_t)row * (W_) + 2 * ((B_) + q_) + 1] = s_; } } while (0)
      for (int it = gtid; it < S_ * 6; it += gsz) { const int row = it / 6, g = it - row * 6; const float pf = (float)P.pos[row];
          switch (g) { case 0: ROPE_TAB(csa, 32, P.invf_a, 0); break; case 1: ROPE_TAB(csa, 32, P.invf_a, 8); break;
                       case 2: ROPE_TAB(csb, 64, P.invf_b, 0); break; case 3: ROPE_TAB(csb, 64, P.invf_b, 8); break;
                       case 4: ROPE_TAB(csb, 64, P.invf_b, 16); break; default: ROPE_TAB(csb, 64, P.invf_b, 24); break; } }
#undef ROPE_TAB
    }
    { bf16_t* xn = (bf16_t*)(ws + WS_ACT + A_XN);
      for (int row = blockIdx.x * 8 + wid; row < S_; row += gridDim.x * 16) { const int rowb = row + gridDim.x * 8 < S_ ? row + gridDim.x * 8 : row;
          const f32x4* xr = (const f32x4*)(P.x + (size_t)row * DM); const f32x4* xs = (const f32x4*)(P.x + (size_t)rowb * DM); f32x4 v[8], u[8]; float ss = 0.f, st = 0.f;
#pragma unroll
          for (int i = 0; i < 8; ++i) { v[i] = __builtin_nontemporal_load(xr + lane + 64 * i); u[i] = __builtin_nontemporal_load(xs + lane + 64 * i); }
#pragma unroll
          for (int i = 0; i < 8; ++i) { ss += sq4(v[i]); st += sq4(u[i]); }
#pragma unroll
          for (int off = 32; off >= 1; off >>= 1) { ss += __shfl_xor(ss, off); st += __shfl_xor(st, off); }
          const float r = rstd_of(ss, 1.0f / 2048.0f), r2 = rstd_of(st, 1.0f / 2048.0f);
#pragma unroll
          for (int i = 0; i < 8; ++i) { const f32x4 g = ((const f32x4*)P.attn_norm)[lane + 64 * i]; const f32x4 y = v[i] * r * g, z = u[i] * r2 * g;
              uint2 w; w.x = cvt_pk_bf16(y[0], y[1]); w.y = cvt_pk_bf16(y[2], y[3]); ((uint2*)(xn + (size_t)row * DM))[lane + 64 * i] = w;
              uint2 w2; w2.x = cvt_pk_bf16(z[0], z[1]); w2.y = cvt_pk_bf16(z[2], z[3]); ((uint2*)(xn + (size_t)rowb * DM))[lane + 64 * i] = w2; } } }
    {
      const int nw = gridDim.x * 8; int t = blockIdx.x * 8 + wid;
      if (t < 14912) { int lt; WJob J = wjob_of(P, ws, t, lt); float v[64]; bool has = wtile_load(J, lt % J.ntn, lt / J.ntn, lane, v);
          for (;;) { const int t2 = t + nw; int lt2 = 0; WJob J2 = J; float w[64]; bool has2 = false;
              if (t2 < 14912) { J2 = wjob_of(P, ws, t2, lt2); has2 = wtile_load(J2, lt2 % J2.ntn, lt2 / J2.ntn, lane, w); }
              wtile_store(J, lt % J.ntn, lt / J.ntn, lane, v, has);
              if (t2 >= 14912) break;
#pragma unroll
              for (int i = 0; i < 64; ++i) v[i] = w[i];
              J = J2; lt = lt2; has = has2; t = t2; } } }
}
constexpr int L_TRI = 256 * 2016;
__host__ __device__ __forceinline__ int l_tri(int j) { return 256 * (63 * j - (j * (j - 1)) / 2); }
__device__ __forceinline__ void moba_gate(const Params& P, char* lds) {
    const int tid = threadIdx.x; float* km = (float*)lds; unsigned char* ws = P.ws;
    const float* kms = (const float*)(ws + WS_KMS); const bf16_t* qa = (const bf16_t*)(ws + WS_ACT + A_QA); unsigned* lcnt = (unsigned*)(ws + WS_CTL) + 256; unsigned short* list = (unsigned short*)(ws + WS_ACT + A_LIST);
    for (int item = blockIdx.x; item < 256; item += gridDim.x) { const int h = item & 7, pp = item >> 3;
        __syncthreads();
        for (int i = tid; i < 8192; i += 512) km[i] = kms[h * 8192 + i] * (1.0f / 256.0f);
        __syncthreads();
        const int row = tid < 256 ? pp * 256 + tid : (63 - pp) * 256 + (tid - 256), blk = row >> 8, nblk = __builtin_amdgcn_readfirstlane(blk);
        const u32x4* qp = (const u32x4*)(qa + (size_t)row * 1024 + h * 128); u32x4 q[16];
#pragma unroll
        for (int i = 0; i < 16; ++i) q[i] = qp[i];
        float b1 = -__builtin_inff(), b2 = b1, b3 = b1; int i1 = 0, i2 = 0, i3 = 0;
        for (int n = 0; n < nblk; ++n) { const f32x4* kr = (const f32x4*)(km + n * 128); float a0 = 0.f, a1 = 0.f;
#pragma unroll
            for (int i = 0; i < 16; ++i) { const f32x4 ka = kr[2 * i], kb = kr[2 * i + 1]; const u32x4 qq = q[i];
                a0 += bflo(qq.x) * ka[0] + bfhi(qq.x) * ka[1] + bflo(qq.y) * ka[2] + bfhi(qq.y) * ka[3];
                a1 += bflo(qq.z) * kb[0] + bfhi(qq.z) * kb[1] + bflo(qq.w) * kb[2] + bfhi(qq.w) * kb[3]; }
            const float g = a0 + a1;
            if (g > b1) { b3 = b2; i3 = i2; b2 = b1; i2 = i1; b1 = g; i1 = n; }
            else if (g > b2) { b3 = b2; i3 = i2; b2 = g; i2 = n; }
            else if (g > b3) { b3 = g; i3 = n; } }
        if (blk >= 1) { const unsigned p = atomicAdd(lcnt + h * 64 + i1, 1u); list[(size_t)h * L_TRI + l_tri(i1) + p] = (unsigned short)(row); }
        if (blk >= 2) { const unsigned p = atomicAdd(lcnt + h * 64 + i2, 1u); list[(size_t)h * L_TRI + l_tri(i2) + p] = (unsigned short)(row | (1 << 14)); }
        if (blk >= 3) { const unsigned p = atomicAdd(lcnt + h * 64 + i3, 1u); list[(size_t)h * L_TRI + l_tri(i3) + p] = (unsigned short)(row | (2 << 14)); } }
}
__device__ __forceinline__ void grid_bar(unsigned* cnt, unsigned& target, unsigned G) {
    asm volatile("s_waitcnt vmcnt(0)" ::: "memory");
    __syncthreads();
    target += G;
    if (threadIdx.x == 0) {
        __builtin_amdgcn_fence(__ATOMIC_RELEASE, "agent");
        asm volatile("s_waitcnt vmcnt(0)" ::: "memory");
        __hip_atomic_fetch_add(cnt, 1u, __ATOMIC_RELAXED, __HIP_MEMORY_SCOPE_AGENT);
        while (__hip_atomic_load(cnt, __ATOMIC_RELAXED, __HIP_MEMORY_SCOPE_AGENT) < target) __builtin_amdgcn_s_sleep(1);
        __builtin_amdgcn_fence(__ATOMIC_ACQUIRE, "agent");
        asm volatile("s_waitcnt vmcnt(0)" ::: "memory");
    }
    __syncthreads();
}
constexpr int LDS_BYTES = pg8::STAGE_BYTES;
__global__ void __launch_bounds__(512, 2) hybrid_fwd(Params P) {
    extern __shared__ __attribute__((aligned(16))) unsigned char lds_raw[];
    char* lds = (char*)lds_raw; PG8_LAS unsigned char* ldsg = (PG8_LAS unsigned char*)lds_raw;
    unsigned char* ws = P.ws; unsigned char* wa = ws + WS_ACT;
    const int tid = threadIdx.x, G = gridDim.x, c = blockIdx.x;
    const int lo = P.ph_lo, hi = P.ph_hi;
    float* ssq = (float*)(ws + WS_SSQ); float* ssq_q = ssq, * ssq_kv = ssq + S_, * ssq_h = ssq + 2 * S_, * ssq_o = ssq + 3 * S_;
    bf16_t* gates = (bf16_t*)P.out;
#ifndef PHMASK
#define PHMASK 0x3ff
#endif
#define IN(k) (((PHMASK >> (k)) & 1) && lo <= (k) && (k) < hi)
    unsigned bar_target = 0; unsigned* bar_cnt = (unsigned*)(ws + WS_BAR);
#define SEAM(k) do { if (IN(k) && IN((k) + 1)) { if (lo < 0) cg::this_grid().sync(); else grid_bar(bar_cnt, bar_target, (unsigned)G); } } while (0)
#ifndef NREP0
#define NREP0 1
#endif
#ifndef NREP3
#define NREP3 1
#endif
#ifndef NREP7
#define NREP7 1
#endif
    if (IN(0)) for (int rep = 0; rep < NREP0; ++rep) { if (rep) cg::this_grid().sync(); phase0(P, lds); }
    SEAM(0);
    if (IN(1)) {
        pg8::Gemm g{(const bf16_t*)(wa + A_XN), (const bf16_t*)(ws + WS_WIN), S_, 8192, 2048}; pg8::StaticOrder so; so.init(S_, 8192, G, c);
        EpiProj E{(bf16_t*)(wa + A_QA), (bf16_t*)(wa + A_KA), (bf16_t*)(wa + A_VA), (bf16_t*)(wa + A_CQ), (bf16_t*)(wa + A_CKV), (bf16_t*)(wa + A_KRP), gates,
                  (const float*)(ws + WS_CSA), (const float*)(ws + WS_CSB), (float*)(ws + WS_KMS), ssq_q, ssq_kv};
        pg8::gemm_phase<EpiProj, pg8::StaticOrder, false>(ldsg, g, so, E, nullptr);
    }
    SEAM(1);
    if (IN(2)) {
#ifndef NO_G2A
        { pg8::Gemm g{(const bf16_t*)(wa + A_CQ), (const bf16_t*)(ws + WS_WUQ), S_, 1536, 512}; pg8::StaticOrder so; so.init(S_, 1536, G, c);
          EpiQ E{(bf16_t*)(wa + A_QN), (bf16_t*)(wa + A_QRP), (const float*)(ws + WS_CSB), ssq_q};
          pg8::gemm_phase<EpiQ, pg8::StaticOrder, false>(ldsg, g, so, E, nullptr); }
#endif
#ifndef NO_G2B
        { int kk = 256; asm volatile("" : "+s"(kk));
          pg8::Gemm g{(const bf16_t*)(wa + A_CKV), (const bf16_t*)(ws + WS_WUKV), S_, 2048, kk}; pg8::StaticOrder so; so.init(S_, 2048, G, c);
          EpiKV E{(bf16_t*)(wa + A_KN), (bf16_t*)(wa + A_VB), ssq_kv};
          pg8::gemm_phase<EpiKV, pg8::StaticOrder, false>(ldsg, g, so, E, nullptr); }
#endif
#ifndef NO_GATE
        moba_gate(P, lds);
#endif
    }
    SEAM(2);
    if (IN(3)) {
        for (int rep = 0; rep < NREP3; ++rep) { if (rep) cg::this_grid().sync();
        unsigned* ctr = (unsigned*)(ws + WS_CTL) + rep * 8; int* itp = (int*)(lds + att::OFF_MISC + 64 + 67 * 4);
        const unsigned* lcnt = (unsigned*)(ws + WS_CTL) + 256; int* pre = (int*)(lds + att::OFF_Q2);
        bf16_t* ya = (bf16_t*)(wa + A_Y);
        att::AttnIO mla{(const bf16_t*)(wa + A_QN), (const bf16_t*)(wa + A_QRP), (const bf16_t*)(wa + A_KN), (const bf16_t*)(wa + A_KRP), (const bf16_t*)(wa + A_VB), ya + (size_t)S_ * 1024, 0LL, nullptr, nullptr};
        att::AttnIO mob{(const bf16_t*)(wa + A_QA), nullptr, (const bf16_t*)(wa + A_KA), nullptr, (const bf16_t*)(wa + A_VA), ya, 0LL, (float2*)(wa + A_ML), nullptr};
        att::AttnIO gat{(const bf16_t*)(wa + A_QA), nullptr, (const bf16_t*)(wa + A_KA), nullptr, (const bf16_t*)(wa + A_VA), (bf16_t*)(wa + A_P0), (long long)((bf16_t*)(ws + WS_WIN) - ((bf16_t*)(wa + A_P0) + 2 * (size_t)S_ * 1024)), (float2*)(wa + A_ML), (const unsigned short*)(wa + A_LIST)};
        unsigned* mq = (unsigned*)(ws + WS_CTL) + 32; unsigned* gq = (unsigned*)(ws + WS_CTL) + 48; const int x0 = (int)(blockIdx.x & 7);
        for (int kx = 0; kx < 8; ++kx) { const int hx = (x0 + kx) & 7;
            for (;;) {
                if (tid == 0) *itp = (int)atomicAdd(mq + hx, 1u);
                __syncthreads();
                const int it = __builtin_amdgcn_readfirstlane(*itp);
                __syncthreads();
                if (it >= 64) break;
                att::attn_item<0>(lds, mla, hx, 63 - it, 0, 0, 1.4426950408889634f * 0.07216878364870323f);
            } }
        { const int hh = tid >> 6, jj = tid & 63; int* tot = pre + 512;
          const int v = jj < 63 ? (int)((lcnt[hh * 64 + jj] + 255u) >> 8) : 0; int inc = v;
#pragma unroll
          for (int off = 1; off < 64; off <<= 1) { const int n_ = __shfl_up(inc, off); if (jj >= off) inc += n_; }
          if (jj == 63) tot[hh] = inc;
          __syncthreads();
          int base = 0;
#pragma unroll
          for (int q = 0; q < 8; ++q) base += (q < hh) ? tot[q] : 0;
          if (jj < 63) pre[hh * 63 + jj] = base + inc - v;
          if (tid == 511) pre[504] = base + inc; }
        __syncthreads();
        { const int ngat = __builtin_amdgcn_readfirstlane(pre[504]);
          for (int it = c; it < ngat; it += G) { int lo_ = 0, hi_ = 503;
              while (lo_ < hi_) { const int mid = (lo_ + hi_ + 1) >> 1; if (__builtin_amdgcn_readfirstlane(pre[mid]) <= it) lo_ = mid; else hi_ = mid - 1; }
              const int pr = lo_, h = pr / 63, j = pr % 63, cch = it - __builtin_amdgcn_readfirstlane(pre[pr]); const int cnt = (int)lcnt[h * 64 + j];
              const int nv = cnt - cch * 256 < 256 ? cnt - cch * 256 : 256;
              att::attn_item<2>(lds, gat, h, j, h * L_TRI + l_tri(j) + cch * 256, nv, 1.4426950408889634f * 0.08838834764831845f); } }
        for (int it = c; it < 512; it += G)
            att::attn_item<1>(lds, mob, it & 7, it >> 3, 0, 0, 1.4426950408889634f * 0.08838834764831845f);
        }
    }
    SEAM(3);
    if (IN(4)) {
        const float2* ml = (const float2*)(wa + A_ML); bf16_t* ya = (bf16_t*)(wa + A_Y);
        const bf16_t* pp0 = (const bf16_t*)(wa + A_P0); const bf16_t* pp1 = (const bf16_t*)(wa + A_P1); const bf16_t* pp2 = (const bf16_t*)(ws + WS_WIN);
        const int lane = tid & 63, wid = tid >> 6, h = lane >> 3;
#define MRG_ACC(a_, b_, w_) do { const float w__ = (w_);                                                                                      \
            c0[0] += w__ * bflo(a_.x); c0[1] += w__ * bfhi(a_.x); c0[2] += w__ * bflo(a_.y); c0[3] += w__ * bfhi(a_.y);                          \
            c1[0] += w__ * bflo(a_.z); c1[1] += w__ * bfhi(a_.z); c1[2] += w__ * bflo(a_.w); c1[3] += w__ * bfhi(a_.w);                          \
            c2[0] += w__ * bflo(b_.x); c2[1] += w__ * bfhi(b_.x); c2[2] += w__ * bflo(b_.y); c2[3] += w__ * bfhi(b_.y);                          \
            c3[0] += w__ * bflo(b_.z); c3[1] += w__ * bfhi(b_.z); c3[2] += w__ * bflo(b_.w); c3[3] += w__ * bfhi(b_.w); } while (0)
#define MRG_LD(ptr, A_, B_) do { A_ = *(const u32x4*)((ptr) + eo); B_ = *(const u32x4*)((ptr) + eo + 8); } while (0)
        for (int row = c * 8 + wid; row < S_; row += G * 8) { const int blk = row >> 8; const size_t mo = ((size_t)row * 8 + h) * 4, eo = (size_t)row * 1024 + lane * 16;
            const float2 s3 = ml[mo + 3]; float2 s0 = make_float2(-1e30f, 0.f), s1 = s0, s2 = s0;
            u32x4 ya_a, ya_b, p0a = {0, 0, 0, 0}, p0b = p0a, p1a = p0a, p1b = p0a, p2a = p0a, p2b = p0a;
            MRG_LD(ya, ya_a, ya_b);
            if (blk >= 1) { s0 = ml[mo]; MRG_LD(pp0, p0a, p0b); } if (blk >= 2) { s1 = ml[mo + 1]; MRG_LD(pp1, p1a, p1b); } if (blk >= 3) { s2 = ml[mo + 2]; MRG_LD(pp2, p2a, p2b); }
            const float M = fmaxf(fmaxf(s3.x, s0.x), fmaxf(s1.x, s2.x));
            const float w3 = s3.y * __builtin_amdgcn_exp2f(s3.x - M), w0 = s0.y * __builtin_amdgcn_exp2f(s0.x - M), w1 = s1.y * __builtin_amdgcn_exp2f(s1.x - M), w2 = s2.y * __builtin_amdgcn_exp2f(s2.x - M);
            f32x4 c0 = {0.f, 0.f, 0.f, 0.f}, c1 = c0, c2 = c0, c3 = c0;
            MRG_ACC(ya_a, ya_b, w3); MRG_ACC(p0a, p0b, w0); MRG_ACC(p1a, p1b, w1); MRG_ACC(p2a, p2b, w2);
            const float inv = 1.0f / (w3 + w0 + w1 + w2);
            st8(ya + eo, c0 * inv, c1 * inv); st8(ya + eo + 8, c2 * inv, c3 * inv); }
#undef MRG_LD
#undef MRG_ACC
    }
    SEAM(4);
    if (IN(5)) {
        pg8::Gemm g{(const bf16_t*)(wa + A_Y), (const bf16_t*)(ws + WS_WBR), 2 * S_, 4096, 1024}; BranchOrder bo; bo.init(G, c);
        EpiBranch E{gates, (bf16_t*)(wa + A_T), (bf16_t*)(wa + A_MIX)};
        pg8::gemm_phase<EpiBranch, BranchOrder, false>(ldsg, g, bo, E, nullptr);
    }
    SEAM(5);
    if (IN(6)) {
        pg8::Gemm g{(const bf16_t*)(wa + A_MIX), (const bf16_t*)(ws + WS_WOUT), S_, 2048, 2048}; pg8::StaticOrder so; so.init(S_, 2048, G, c);
        EpiOut E{P.x, (float*)(wa + A_HF), (bf16_t*)(wa + A_HB), ssq_h};
        pg8::gemm_phase<EpiOut, pg8::StaticOrder, false>(ldsg, g, so, E, nullptr);
    }
    SEAM(6);
    if (IN(7)) {
        pg8::Gemm g{(const bf16_t*)(wa + A_HB), (const bf16_t*)(ws + WS_WGU), S_, 11264, 2048}; pg8::StaticOrder so; so.init(S_, 11264, G, c);
        EpiGU E{(bf16_t*)(wa + A_ACTV), ssq_h};
        for (int rep = 0; rep < NREP7; ++rep) { if (rep) cg::this_grid().sync(); pg8::gemm_phase<EpiGU, pg8::StaticOrder, false>(ldsg, g, so, E, nullptr); }
    }
    SEAM(7);
    if (IN(8)) {
        pg8::Gemm g{(const bf16_t*)(wa + A_ACTV), (const bf16_t*)(ws + WS_WDN), S_, 2048, DFF}; pg8::StaticOrder so; so.init(S_, 2048, G, c);
        EpiDown E{(const float*)(wa + A_HF), P.out, ssq_o};
        pg8::gemm_phase<EpiDown, pg8::StaticOrder, false>(ldsg, g, so, E, nullptr);
    }
    SEAM(8);
    if (IN(9)) {
        const int lane = tid & 63, wid = tid >> 6;
        for (int row = c * 8 + wid; row < S_; row += G * 8) { const float r = rstd_of(ssq_o[row], 1.0f / 2048.0f); f32x4* op = (f32x4*)(P.out + (size_t)row * DM);
#pragma unroll
            for (int i = 0; i < 8; ++i) { const f32x4 g = ((const f32x4*)P.final_norm)[lane + 64 * i]; op[lane + 64 * i] = op[lane + 64 * i] * r * g; } }
    }
#undef IN
#undef SEAM
}

#ifndef MK_FUSED
#define MK_FUSED 0
#endif
extern "C" void kernel_launch(void* const* d_in, const int* in_sizes, int n_in, void* d_out, int out_size, void* d_ws, size_t ws_size, hipStream_t stream) {
    static int grid = 0;
    if (grid == 0) {
        int dev = 0, cus = 0, per_cu = 0;
        (void)hipGetDevice(&dev); (void)hipDeviceGetAttribute(&cus, hipDeviceAttributeMultiprocessorCount, dev);
        if (hipFuncSetAttribute((const void*)hybrid_fwd, hipFuncAttributeMaxDynamicSharedMemorySize, LDS_BYTES) != hipSuccess) fprintf(stderr, "hipFuncSetAttribute failed\n");
        if (hipOccupancyMaxActiveBlocksPerMultiprocessor(&per_cu, (const void*)hybrid_fwd, 512, LDS_BYTES) != hipSuccess || per_cu < 1) { fprintf(stderr, "occupancy query: %d\n", per_cu); per_cu = 1; }
        (void)hipGetLastError();
        if (cus <= 0) cus = 256;
        grid = cus * (per_cu > 1 ? 1 : per_cu);
        if (ws_size < WS_END) fprintf(stderr, "kernel_launch: workspace %zu < %zu\n", ws_size, (size_t)WS_END);
    }
    (void)hipMemsetAsync((char*)d_ws + WS_BAR, 0, 256, stream);
    Params p{};
    p.x = (const float*)d_in[0]; p.pos = (const int*)d_in[1]; p.attn_norm = (const float*)d_in[2]; p.w_in = (const float*)d_in[3]; p.q_norm = (const float*)d_in[4];
    p.w_uq = (const float*)d_in[5]; p.kv_norm = (const float*)d_in[6]; p.w_ukv = (const float*)d_in[7]; p.w_ba = (const float*)d_in[8]; p.w_bb = (const float*)d_in[9];
    p.w_out = (const float*)d_in[10]; p.ffn_norm = (const float*)d_in[11]; p.w_gate = (const float*)d_in[12]; p.w_up = (const float*)d_in[13]; p.w_down = (const float*)d_in[14];
    p.final_norm = (const float*)d_in[15]; p.out = (float*)d_out; p.ws = (unsigned char*)d_ws;
    for (int i = 0; i < 16; ++i) p.invf_a[i] = (float)std::pow(500000.0, -(double)(2 * i) / 32.0);
    for (int i = 0; i < 32; ++i) p.invf_b[i] = (float)std::pow(500000.0, -(double)(2 * i) / 64.0);
#if MK_FUSED
    p.ph_lo = 0; p.ph_hi = 10;
    void* args[] = {&p};
    hipError_t e = hipLaunchCooperativeKernel((const void*)hybrid_fwd, dim3(grid), dim3(512), args, LDS_BYTES, stream);
    if (e != hipSuccess) fprintf(stderr, "cooperative launch failed: %s (grid %d)\n", hipGetErrorString(e), grid);
#else
    for (int ph = 0; ph < 10; ++ph) { p.ph_lo = ph; p.ph_hi = ph + 1; hipLaunchKernelGGL(hybrid_fwd, dim3(grid), dim3(512), LDS_BYTES, stream, p); }

#endif
}
```
